# Optimizing an MI355X kernel written in HIP

```python
import jax, jax.numpy as jnp
from jax import lax
import numpy as np

D_MODEL = 1024
BATCH = 8
SEQ = 2048
DEPTH = 1
DEC_BATCH = 128
DEC_SEQ = 1
PAST_LEN = 16384
PAGE_SIZE = 128

D_A = D_MODEL
CHUNK = 128
N_GROUPS_A = D_A // CHUNK
GD_A = D_A // N_GROUPS_A
D_B = D_MODEL
POOL_WINDOWS = (2, 4, 8, 16)
N_GROUPS_B = len(POOL_WINDOWS)
GD_B = D_B // N_GROUPS_B
POOL_BUF = max(POOL_WINDOWS) - 1
PLE_DIM = 256
EPS = 1e-6
SPLITS = (D_A, 2 * D_A, 3 * D_A, 3 * D_A + D_B, 3 * D_A + 2 * D_B, 3 * D_A + 2 * D_B + D_MODEL)
D_IN = 3 * D_A + 2 * D_B + 2 * D_MODEL

kernel_name = "gated_chunk_gmlp_pool_hybrid_step"


def _rmsnorm(x, g):
    x32 = x.astype(jnp.float32)
    r = x32 * lax.rsqrt(jnp.mean(x32 * x32, axis=-1, keepdims=True) + EPS)
    return (r * g.astype(jnp.float32)).astype(x.dtype)


def _layernorm(x, g, b):
    x32 = x.astype(jnp.float32)
    mu = jnp.mean(x32, axis=-1, keepdims=True)
    xc = x32 - mu
    r = xc * lax.rsqrt(jnp.mean(xc * xc, axis=-1, keepdims=True) + EPS)
    return (r * g.astype(jnp.float32) + b.astype(jnp.float32)).astype(x.dtype)


def _chunk_spatial_mix(vn, w_s, b_s):
    bn, L, _ = vn.shape
    pad = (-L) % CHUNK
    vp = jnp.pad(vn, ((0, 0), (0, pad), (0, 0)))
    nc = (L + pad) // CHUNK
    vp = vp.reshape(bn, nc, CHUNK, N_GROUPS_A, GD_A)
    w = jnp.tril(w_s)
    s = jnp.einsum('hts,bcshd->bcthd', w, vp) + jnp.transpose(b_s)[None, None, :, :, None]
    return s.reshape(bn, nc * CHUNK, D_A)[:, :L]


def _pool_branch(xb, prev, pos0, w_lin, scale):
    bn, L, _ = xb.shape
    ext = jnp.concatenate([prev, xb], axis=1)
    e32 = ext.astype(jnp.float32)
    cs = jnp.concatenate([jnp.zeros_like(e32[:, :1]), jnp.cumsum(e32, axis=1)], axis=1)
    pos = pos0 + jnp.arange(L, dtype=jnp.int32)
    x32 = xb.astype(jnp.float32)
    outs = []
    for g, w in enumerate(POOL_WINDOWS):
        sl = slice(g * GD_B, (g + 1) * GD_B)
        win_sum = (cs[:, POOL_BUF + 1:POOL_BUF + 1 + L, sl]
                   - cs[:, POOL_BUF + 1 - w:POOL_BUF + 1 - w + L, sl])
        cnt = jnp.minimum(pos + 1, w).astype(jnp.float32)[None, :, None]
        outs.append(win_sum / cnt - x32[..., sl])
    pooled = jnp.stack(outs, axis=2).astype(xb.dtype)
    mixed = jnp.einsum('blgc,gcd->blgd', pooled, w_lin).reshape(bn, L, D_B) * scale
    return mixed, ext[:, -POOL_BUF:]


def _layer(h, p, prev_pool, pos0, pre_g, w_in, ln_g, ln_b, w_s, b_s, w_pool, pool_scale,
           w_pa, w_pb, w_out, post_g, w_ple, w_pg, ple_in_g, ple_out_g):
    L = h.shape[1]
    xn = _rmsnorm(h, pre_g)
    proj = jnp.einsum('bld,de->ble', xn, w_in)
    u, v, z_a, x_b, z_b, g_a, g_b = jnp.split(proj, SPLITS, axis=-1)
    u = jax.nn.gelu(u)
    vn = _layernorm(jax.nn.gelu(v), ln_g, ln_b)
    y_a = u * _chunk_spatial_mix(vn, w_s, b_s) * jax.nn.silu(z_a)
    pooled, new_pool = _pool_branch(x_b, prev_pool, pos0, w_pool, pool_scale)
    y_b = pooled * jax.nn.silu(z_b)
    m = (jax.nn.sigmoid(g_a) * jnp.einsum('ble,ed->bld', y_a, w_pa)
         + jax.nn.sigmoid(g_b) * jnp.einsum('ble,ed->bld', y_b, w_pb))
    h = h + _rmsnorm(jnp.einsum('bld,de->ble', m, w_out), post_g)
    e = jnp.einsum('blp,pd->bld', p, w_ple)
    gate = jax.nn.sigmoid(jnp.einsum('bld,de->ble', _rmsnorm(h, ple_in_g), w_pg))
    h = h + _rmsnorm(gate * e, ple_out_g)
    start = ((L - 1) // CHUNK) * CHUNK
    return h, vn[:, start:], new_pool


def setup_inputs(seed: int = 0) -> dict:
    key = jax.random.key(seed)
    ks = jax.random.split(key, 32)
    f32 = jnp.float32
    nrm = lambda k, shape, s: jax.random.normal(k, shape, f32) * s
    return {
        "x_prompt": nrm(ks[0], (BATCH, SEQ, D_MODEL), 1.0),
        "x_sample": nrm(ks[1], (DEC_BATCH, DEC_SEQ, D_MODEL), 1.0),
        "state_pool": nrm(ks[2], (DEPTH, DEC_BATCH, POOL_BUF, D_B), 1.0),
        "p_prompt": nrm(ks[3], (DEPTH, BATCH, SEQ, PLE_DIM), 1.0),
        "p_sample": nrm(ks[4], (DEPTH, DEC_BATCH, DEC_SEQ, PLE_DIM), 1.0),
        "pre_g": 1.0 + nrm(ks[5], (DEPTH, D_MODEL), 0.02),
        "w_in": nrm(ks[6], (DEPTH, D_MODEL, D_IN), D_MODEL ** -0.5),
        "ln_g": 1.0 + nrm(ks[7], (DEPTH, D_A), 0.02),
        "ln_b": nrm(ks[8], (DEPTH, D_A), 0.02),
        "w_s": nrm(ks[9], (DEPTH, N_GROUPS_A, CHUNK, CHUNK), CHUNK ** -0.5),
        "b_s": 1.0 + nrm(ks[10], (DEPTH, N_GROUPS_A, CHUNK), 0.02),
        "w_pool": nrm(ks[11], (DEPTH, N_GROUPS_B, GD_B, GD_B), GD_B ** -0.5),
        "pool_scale": 1.0 + nrm(ks[12], (DEPTH, D_B), 0.02),
        "w_pa": nrm(ks[13], (DEPTH, D_A, D_MODEL), D_A ** -0.5),
        "w_pb": nrm(ks[14], (DEPTH, D_B, D_MODEL), D_B ** -0.5),
        "w_out": nrm(ks[15], (DEPTH, D_MODEL, D_MODEL), D_MODEL ** -0.5),
        "post_g": 1.0 + nrm(ks[16], (DEPTH, D_MODEL), 0.02),
        "w_ple": nrm(ks[17], (DEPTH, PLE_DIM, D_MODEL), PLE_DIM ** -0.5),
        "w_pg": nrm(ks[18], (DEPTH, D_MODEL, D_MODEL), D_MODEL ** -0.5),
        "ple_in_g": 1.0 + nrm(ks[19], (DEPTH, D_MODEL), 0.02),
        "ple_out_g": 1.0 + nrm(ks[20], (DEPTH, D_MODEL), 0.02),
    }


def reference(x_prompt, x_sample, state_pool, p_prompt, p_sample, pre_g, w_in, ln_g, ln_b,
              w_s, b_s, w_pool, pool_scale, w_pa, w_pb, w_out, post_g, w_ple, w_pg,
              ple_in_g, ple_out_g):
    hp, hs = x_prompt, x_sample
    pv_list, pp_list, sv_list, sp_list = [], [], [], []
    for i in range(DEPTH):
        lw = (pre_g[i], w_in[i], ln_g[i], ln_b[i], w_s[i], b_s[i], w_pool[i], pool_scale[i],
              w_pa[i], w_pb[i], w_out[i], post_g[i], w_ple[i], w_pg[i], ple_in_g[i], ple_out_g[i])
        zero_prev = jnp.zeros((hp.shape[0], POOL_BUF, D_B), hp.dtype)
        hp, pv, pp = _layer(hp, p_prompt[i], zero_prev, 0, *lw)
        hs, sv, sp = _layer(hs, p_sample[i], state_pool[i], PAST_LEN, *lw)
        pv_list.append(pv); pp_list.append(pp); sv_list.append(sv); sp_list.append(sp)
    prompt_chunk_v = jnp.stack(pv_list)
    prompt_pool = jnp.stack(pp_list)
    sample_chunk_v = jnp.stack(sv_list)
    sample_pool = jnp.stack(sp_list)
    return (hp, hs, prompt_chunk_v, prompt_pool, sample_chunk_v, sample_pool)
```

```cpp
#ifndef K_SP2
#define K_SP2 true
#endif
#ifndef K_ALIGN
#define K_ALIGN true
#endif
#include <hip/hip_runtime.h>
#include <hip/hip_cooperative_groups.h>
#include <cstdio>
namespace cg = cooperative_groups;

#define LAS __attribute__((address_space(3)))
typedef unsigned short bf16_t;
typedef short bf16x8 __attribute__((ext_vector_type(8)));
typedef float f32x4 __attribute__((ext_vector_type(4)));
typedef float f32x2 __attribute__((ext_vector_type(2)));
typedef unsigned u32x4 __attribute__((ext_vector_type(4)));
typedef unsigned u32x2 __attribute__((ext_vector_type(2)));

constexpr int DM = 1024, MPR = 16384, MSM = 128, MREAL = MPR + MSM, MT = 16640, DIN = 7168, PLE = 256, SEQ = 2048;
constexpr int NTHR = 512;
constexpr int XCD_BAR_WORDS_C = 3456;
constexpr int LDS_BYTES = 131072 + 64 + 8192;
constexpr float EPS = 1e-6f;
constexpr int C_U = 0, C_ZB = 1024, C_V = 2048, C_ZA = 3072, C_XB = 4096, C_GA = 5120, C_GB = 6144;
constexpr int C_M = 2048;
constexpr int C_E = 2048;
constexpr int C_T = 3072;
constexpr int C_GE = 5120;
constexpr int LDF = DIN / 2;
constexpr int CF_T = 1536;
constexpr int CF_GE = 2560;
constexpr size_t O_YP = 0, O_YS = (size_t)MPR * DM, O_PCV = O_YS + (size_t)MSM * DM, O_PP = O_PCV + (size_t)8 * 128 * DM,
                 O_SCV = O_PP + (size_t)8 * 15 * DM, O_SP = O_SCV + (size_t)MSM * DM;
constexpr size_t DO_XN = 0, DO_WIN = (size_t)MT * DM * 2;
constexpr size_t WS_ACT = 0;
constexpr size_t WS_WCAT = WS_ACT + (size_t)MT * DIN * 2;
constexpr size_t WS_WOUT = WS_WCAT + (size_t)1024 * 2048 * 2;
constexpr size_t WS_W6 = WS_WOUT + (size_t)1024 * 1024 * 2;
constexpr size_t WS_WPOOL = WS_W6 + (size_t)1024 * 1280 * 2;
constexpr size_t WS_WS = WS_WPOOL + (size_t)4 * 256 * 256 * 2;
constexpr size_t WS_STATV = WS_WS + (size_t)8 * 128 * 128 * 2;
constexpr size_t WS_STATT = WS_STATV + (size_t)MT * 16 * 2 * 4;
constexpr size_t WS_STATG = WS_STATT + (size_t)MT * 16 * 4;
constexpr size_t WS_BAR = WS_STATG + (size_t)MT * 16 * 4;
constexpr size_t WS_XCNT = WS_BAR + (size_t)XCD_BAR_WORDS_C * 4;
constexpr size_t WS_XBUF = WS_XCNT + (size_t)3 * 64 * 64 * 4;
constexpr size_t ZERO_BYTES = WS_XBUF - WS_BAR;
constexpr size_t WS_SVS = WS_XBUF + (size_t)3 * 64 * 256 * 4 * 4;
constexpr size_t WS_STS = WS_SVS + (size_t)MSM * 64 * 2 * 4;
constexpr size_t WS_SGS = WS_STS + (size_t)MSM * 64 * 4;
constexpr size_t WS_RSTD1 = WS_SGS + (size_t)MSM * 64 * 4;
constexpr size_t WS_END = WS_RSTD1 + (size_t)MPR * 4;

struct Params {
    const float* x_prompt; const float* x_sample; const float* state_pool; const float* p_prompt; const float* p_sample;
    const float* pre_g; const float* w_in; const float* ln_g; const float* ln_b; const float* w_s; const float* b_s;
    const float* w_pool; const float* pool_scale; const float* w_pa; const float* w_pb; const float* w_out; const float* post_g;
    const float* w_ple; const float* w_pg; const float* ple_in_g; const float* ple_out_g;
    float* out; unsigned char* ws;
};

typedef __bf16 bf16x2_t __attribute__((ext_vector_type(2)));
__device__ __forceinline__ unsigned cvt_pk_bf16(float lo, float hi) { const bf16x2_t r = __builtin_convertvector((f32x2){lo, hi}, bf16x2_t); return __builtin_bit_cast(unsigned, r); }
__device__ __forceinline__ float bf_lo(unsigned w) { return __uint_as_float(w << 16); }
__device__ __forceinline__ float bf_hi(unsigned w) { return __uint_as_float(w & 0xffff0000u); }
__device__ __forceinline__ float sigm(float x) { return __builtin_amdgcn_rcpf(1.0f + __builtin_amdgcn_exp2f(-1.44269504089f * x)); }
__device__ __forceinline__ float gelu_t(float x) { return x * __builtin_amdgcn_rcpf(1.0f + __builtin_amdgcn_exp2f(x * (-2.30220819f - 0.10294324f * x * x))); }
__device__ __forceinline__ float wave_sum(float v) {
#pragma unroll
    for (int o = 32; o >= 1; o >>= 1) v += __shfl_xor(v, o);
    return v;
}


#define XB_TMO      128
#define XB_XCNT(j)  (256  + 64 * (j))
#define XB_XSUB(j)  (1280 + 64 * (j))
#define XB_XGEN(j)  (2304 + 64 * (j))
#define XB_TOP      3328
#define XB_TOPGEN   3392
#define XCD_BAR_WORDS 3456
#define XB_SPIN_CAP (1u << 18)
__device__ __forceinline__ unsigned xb_ld(unsigned* p)              { return __hip_atomic_load(p, __ATOMIC_RELAXED, __HIP_MEMORY_SCOPE_AGENT); }
__device__ __forceinline__ unsigned xb_add(unsigned* p, unsigned v) { return __hip_atomic_fetch_add(p, v, __ATOMIC_RELAXED, __HIP_MEMORY_SCOPE_AGENT); }
__device__ __forceinline__ unsigned xb_xcc_id() { return (unsigned)__builtin_amdgcn_s_getreg((3 << 11) | 20) & 0xFu; }
#define XB_SPIN(cond, bar) do { unsigned _sp = 0; while (cond) { __builtin_amdgcn_s_sleep(1); \
    if ((++_sp & 255u) == 0u) { if (xb_ld(&(bar)[XB_TMO])) break; if (_sp > XB_SPIN_CAP) { atomicAdd(&(bar)[XB_TMO], 1u); break; } } } } while (0)
struct XcdBarrier { unsigned* bar; unsigned x; volatile LAS unsigned* st; };
__device__ __forceinline__ XcdBarrier xcd_barrier_post(unsigned* bar, volatile LAS unsigned* st) {
    XcdBarrier b; b.bar = bar; b.x = xb_xcc_id(); b.st = st;
    if (threadIdx.x == 0) (void)xb_add(&bar[XB_XCNT(b.x)], 1u);
    return b;
}
__device__ __forceinline__ void xcd_barrier_complete(unsigned* bar, unsigned x, unsigned& nloc, unsigned& nx) {
    const unsigned G = gridDim.x * gridDim.y * gridDim.z;
    unsigned sum, cnt, mine, sp = 0u;
    for (;;) {
        sum = 0u; cnt = 0u; mine = 0u;
#pragma unroll
        for (unsigned j = 0; j < 16; ++j) { const unsigned c = xb_ld(&bar[XB_XCNT(j)]); sum += c; cnt += (c > 0u) ? 1u : 0u; mine = (j == x) ? c : mine; }
        if (sum == G) break;
        __builtin_amdgcn_s_sleep(1);
        if ((++sp & 255u) == 0u) { if (xb_ld(&bar[XB_TMO])) break; if (sp > XB_SPIN_CAP) { atomicAdd(&bar[XB_TMO], 1u); break; } }
    }
    nloc = mine > 0u ? mine : 1u; nx = cnt > 0u ? cnt : 1u;
}
__device__ __forceinline__ void xcd_barrier(const XcdBarrier& b) {
    asm volatile("s_waitcnt vmcnt(0)" ::: "memory");
    __syncthreads();
    if (threadIdx.x == 0) {
        unsigned* bar = b.bar;
        __builtin_amdgcn_s_waitcnt(0);
        unsigned nloc = b.st[0], nx = b.st[1];
        if (nloc == 0u) { xcd_barrier_complete(bar, b.x, nloc, nx); b.st[0] = nloc; b.st[1] = nx; }
        const unsigned old = xb_add(&bar[XB_XSUB(b.x)], 1u);
        const unsigned gen = old / nloc;
        if (old + 1u == (gen + 1u) * nloc) {
            __builtin_amdgcn_fence(__ATOMIC_RELEASE, "agent");
            asm volatile("s_waitcnt vmcnt(0)" ::: "memory");
            const unsigned og = xb_add(&bar[XB_TOP], 1u);
            const unsigned tg = og / nx;
            if (og + 1u == (tg + 1u) * nx) xb_add(&bar[XB_TOPGEN], 1u);
            else XB_SPIN(xb_ld(&bar[XB_TOPGEN]) == tg, bar);
            __builtin_amdgcn_fence(__ATOMIC_ACQUIRE, "agent");
            xb_add(&bar[XB_XGEN(b.x)], 1u);
            asm volatile("s_waitcnt vmcnt(0)" ::: "memory");
        } else {
            XB_SPIN(xb_ld(&bar[XB_XGEN(b.x)]) == gen, bar);
            __builtin_amdgcn_fence(__ATOMIC_ACQUIRE, "agent");
            asm volatile("s_waitcnt vmcnt(0)" ::: "memory");
        }
    }
    __syncthreads();
}

namespace pg8 {
constexpr int BM = 256, BK = 64, HALF = 128, HTB = HALF * BK * 2, STAGE_BYTES = 8 * HTB, NXCD = 8, WGM = 8;
__host__ __device__ __forceinline__ int lds_byte(int r, int c) { const int st = (r >> 4) * 2 + (c >> 5), rr = r & 15, cc = c & 31, ob = rr * 64 + cc * 2; return st * 1024 + (ob ^ (((ob >> 9) & 1) << 5)); }
__host__ __device__ __forceinline__ void stage_rc(int b, int& R, int& C) { const int st = b / 1024, sb = b % 1024, swz = sb ^ (((sb >> 9) & 1) << 5); R = (st >> 1) * 16 + swz / 64; C = (st & 1) * 32 + (swz % 64) / 2; }
__host__ __device__ __forceinline__ int perm32(int rho) { const int n = rho >> 4, i = rho & 15; return 8 * (i >> 2) + 4 * n + (i & 3); }

struct Unit { int pm, pn; };
struct Gemm { const bf16_t* A; const bf16_t* Bt; int lda, ldb, K, a_pn_off; };

struct StaticOrder {
    int nM, nN, nwg, G, c;
    __device__ void init(int nM_, int nN_, int G_, int c_) { nM = nM_; nN = nN_; nwg = nM * nN; G = G_; c = c_; }
    __device__ bool next(int i, Unit& u) const {
        const long L = (long)i * G + c; if (L >= nwg) return false;
        int wgid = (int)L; { const int q = nwg / NXCD, r = nwg % NXCD, xcd = wgid % NXCD, off = wgid / NXCD; wgid = (xcd < r ? xcd * (q + 1) : r * (q + 1) + (xcd - r) * q) + off; }
        const int nig = WGM * nN, gid = wgid / nig, fm = gid * WGM, gsz = (nM - fm) < WGM ? (nM - fm) : WGM;
        u.pm = fm + ((wgid % nig) % gsz); u.pn = (wgid % nig) / gsz; return true;
    }
};

struct NoPre { __device__ __forceinline__ void operator()() const {} };
template <class Epi, class Sched, bool ALIGN_EPI = false, bool SP2 = false, class Pre = NoPre>
__device__ __forceinline__ void gemm_phase(LAS unsigned char* lds, const Gemm g, const Sched& S, const Epi& E, const Pre& pre = Pre()) {
    const int tid = threadIdx.x, wid = __builtin_amdgcn_readfirstlane(tid >> 6), lane = tid & 63, wr = wid >> 2, wc = wid & 3, fr = lane & 15, fq = lane >> 4;
    const int K = g.K, nt = K / BK;
    unsigned voffA[2], voffB[2];
#pragma unroll
    for (int i = 0; i < 2; ++i) { int R, C; stage_rc(tid * 16 + i * 8192, R, C); const int Rb = Epi::PERM ? ((R & ~31) + perm32(R & 31)) : R;
        voffA[i] = (unsigned)(R * g.lda + C) * 2u; voffB[i] = (unsigned)(Rb * g.ldb + C) * 2u; }
    const size_t kstep = (size_t)(BK * 2);
    const size_t hstepA = (size_t)HALF * g.lda * 2, hstepB = (size_t)HALF * g.ldb * 2;
    const size_t tstepA = 2 * hstepA, tstepB = 2 * hstepB;
    const unsigned ldsw = (unsigned)wid * 1024u;
    const int aoff = lds_byte(wr * 64 + fr, fq * 8), boff = lds_byte(wc * 32 + fr, fq * 8);
#define PG8_SA(b, h) (((b) * 2 + (h)) * HTB)
#define PG8_SB(b, h) ((4 + (b) * 2 + (h)) * HTB)
#define PG8_STAGE(bufoff, gbase, voff) do { _Pragma("unroll") for (int _i = 0; _i < 2; ++_i) \
        __builtin_amdgcn_global_load_lds((const unsigned*)((const char*)(gbase) + (voff)[_i]), (LAS unsigned*)(lds + (bufoff) + ldsw + _i * 8192), 16, 0, 0); } while (0)
#define PG8_LDA(dst, b, h) do { _Pragma("unroll") for (int m = 0; m < 4; ++m) _Pragma("unroll") for (int k = 0; k < 2; ++k) dst[m][k] = *(const LAS bf16x8*)(lds + PG8_SA(b, h) + aoff + m * 2048 + k * 1024); } while (0)
#define PG8_LDB(dst, b, h) do { _Pragma("unroll") for (int n = 0; n < 2; ++n) _Pragma("unroll") for (int k = 0; k < 2; ++k) dst[n][k] = *(const LAS bf16x8*)(lds + PG8_SB(b, h) + boff + n * 2048 + k * 1024); } while (0)
#define PG8_MMA(ai, bj, At, Bt) do { __builtin_amdgcn_s_setprio(1); _Pragma("unroll") for (int m = 0; m < 4; ++m) _Pragma("unroll") for (int n = 0; n < 2; ++n) _Pragma("unroll") for (int k = 0; k < 2; ++k) \
        acc[ai][bj][m][n] = __builtin_amdgcn_mfma_f32_16x16x32_bf16(Bt[n][k], At[m][k], acc[ai][bj][m][n], 0, 0, 0); __builtin_amdgcn_s_setprio(0); } while (0)
#define PG8_WAIT_V(n) asm volatile("s_waitcnt vmcnt(" #n ")" ::: "memory")
#define PG8_WAIT_L(n) asm volatile("s_waitcnt lgkmcnt(" #n ")" ::: "memory")
#define PG8_BAR __builtin_amdgcn_s_barrier()
#define PG8_SCHED __builtin_amdgcn_sched_barrier(0)
    Unit cur, nxt; int ui = 0;
    if (!S.next(0, cur)) { pre(); return; }
    f32x4 acc[2][2][4][2];
#pragma unroll
    for (int a = 0; a < 2; ++a)
#pragma unroll
        for (int b = 0; b < 2; ++b)
#pragma unroll
            for (int m = 0; m < 4; ++m)
#pragma unroll
                for (int n = 0; n < 2; ++n) acc[a][b][m][n] = (f32x4){0.f, 0.f, 0.f, 0.f};
    bf16x8 At[4][2], B0[2][2], B1[2][2];
    const char* cA = (const char*)g.A + (size_t)cur.pm * tstepA + (size_t)cur.pn * g.a_pn_off; const char* cB = (const char*)g.Bt + (size_t)cur.pn * tstepB;
    if constexpr (SP2) {
        PG8_STAGE(PG8_SB(0, 0), cB, voffB); PG8_STAGE(PG8_SB(0, 1), cB + hstepB, voffB); PG8_STAGE(PG8_SA(0, 0), cA, voffA); PG8_STAGE(PG8_SA(0, 1), cA + hstepA, voffA);
        pre();
        if (wr == 1) PG8_BAR;
        PG8_WAIT_V(2); PG8_BAR;
        PG8_STAGE(PG8_SB(1, 0), cB + kstep, voffB); PG8_STAGE(PG8_SA(1, 0), cA + kstep, voffA); PG8_STAGE(PG8_SB(1, 1), cB + hstepB + kstep, voffB);
        PG8_WAIT_V(6); PG8_BAR;
    } else {
        PG8_STAGE(PG8_SB(0, 0), cB, voffB); PG8_STAGE(PG8_SA(0, 0), cA, voffA); PG8_STAGE(PG8_SB(0, 1), cB + hstepB, voffB); PG8_STAGE(PG8_SA(0, 1), cA + hstepA, voffA);
        pre();
        if (wr == 1) PG8_BAR;
        PG8_WAIT_V(4); PG8_BAR;
        PG8_STAGE(PG8_SB(1, 0), cB + kstep, voffB); PG8_STAGE(PG8_SA(1, 0), cA + kstep, voffA); PG8_STAGE(PG8_SB(1, 1), cB + hstepB + kstep, voffB);
        PG8_WAIT_V(6); PG8_BAR;
    }
    for (;;) {
        const bool has_next = S.next(ui + 1, nxt);
        const char* nA = has_next ? (const char*)g.A + (size_t)nxt.pm * tstepA + (size_t)nxt.pn * g.a_pn_off : cA; const char* nB = has_next ? (const char*)g.Bt + (size_t)nxt.pn * tstepB : cB;
        int t = 0;
#pragma unroll 1
        for (int seg = 0; seg < (Epi::MID_T >= 0 ? 2 : 1); ++seg) {
        const int tend = (Epi::MID_T >= 0 && seg == 0) ? Epi::MID_T : nt;
#pragma unroll 1
        for (; t < tend; t += 2) {
            const bool last = (t == nt - 2);
            const char* a1 = cA + (size_t)(t + 1) * kstep;
            const char* a2 = last ? nA : cA + (size_t)(t + 2) * kstep; const char* b2 = last ? nB : cB + (size_t)(t + 2) * kstep;
            const char* a3 = a2 + kstep; const char* b3 = b2 + kstep;
            if constexpr (SP2) {
            PG8_LDB(B0, 0, 0); PG8_LDB(B1, 0, 1); PG8_SCHED; PG8_LDA(At, 0, 0); PG8_STAGE(PG8_SA(1, 1), a1 + hstepA, voffA);
            PG8_WAIT_V(8); PG8_WAIT_L(0); PG8_BAR; PG8_MMA(0, 0, At, B0); PG8_MMA(0, 1, At, B1); PG8_BAR; PG8_SCHED;
            PG8_LDA(At, 0, 1); PG8_STAGE(PG8_SB(0, 0), b2, voffB); PG8_STAGE(PG8_SB(0, 1), b2 + hstepB, voffB); PG8_STAGE(PG8_SA(0, 0), a2, voffA);
            PG8_WAIT_V(8); PG8_WAIT_L(0); PG8_BAR; PG8_MMA(1, 0, At, B0); PG8_MMA(1, 1, At, B1); PG8_BAR; PG8_SCHED;
            PG8_LDB(B0, 1, 0); PG8_LDB(B1, 1, 1); PG8_SCHED; PG8_LDA(At, 1, 0); PG8_STAGE(PG8_SA(0, 1), a2 + hstepA, voffA);
            PG8_WAIT_V(8); PG8_WAIT_L(0); PG8_BAR; PG8_MMA(0, 0, At, B0); PG8_MMA(0, 1, At, B1); PG8_BAR; PG8_SCHED;
            PG8_LDA(At, 1, 1); PG8_STAGE(PG8_SB(1, 0), b3, voffB); PG8_STAGE(PG8_SB(1, 1), b3 + hstepB, voffB); PG8_STAGE(PG8_SA(1, 0), a3, voffA);
            PG8_WAIT_V(8); PG8_WAIT_L(0); PG8_BAR; PG8_MMA(1, 0, At, B0); PG8_MMA(1, 1, At, B1); PG8_BAR; PG8_SCHED;
            } else {
            PG8_LDB(B0, 0, 0); PG8_SCHED; PG8_LDA(At, 0, 0); PG8_STAGE(PG8_SA(1, 1), a1 + hstepA, voffA);
            PG8_WAIT_L(8); PG8_BAR; PG8_WAIT_L(0); PG8_MMA(0, 0, At, B0); PG8_BAR; PG8_SCHED;
            PG8_LDB(B1, 0, 1); PG8_STAGE(PG8_SB(0, 0), b2, voffB);
            PG8_BAR; PG8_WAIT_L(0); PG8_MMA(0, 1, At, B1); PG8_BAR;
            PG8_LDA(At, 0, 1); PG8_STAGE(PG8_SA(0, 0), a2, voffA);
            PG8_BAR; PG8_WAIT_L(0); PG8_MMA(1, 0, At, B0); PG8_BAR; PG8_SCHED;
            PG8_STAGE(PG8_SB(0, 1), b2 + hstepB, voffB);
            PG8_WAIT_V(6); PG8_BAR; PG8_MMA(1, 1, At, B1); PG8_BAR;
            PG8_LDB(B0, 1, 0); PG8_SCHED; PG8_LDA(At, 1, 0); PG8_STAGE(PG8_SA(0, 1), a2 + hstepA, voffA);
            PG8_WAIT_L(8); PG8_BAR; PG8_WAIT_L(0); PG8_MMA(0, 0, At, B0); PG8_BAR; PG8_SCHED;
            PG8_LDB(B1, 1, 1); PG8_STAGE(PG8_SB(1, 0), b3, voffB);
            PG8_BAR; PG8_WAIT_L(0); PG8_MMA(0, 1, At, B1); PG8_BAR;
            PG8_LDA(At, 1, 1); PG8_STAGE(PG8_SA(1, 0), a3, voffA);
            PG8_BAR; PG8_WAIT_L(0); PG8_MMA(1, 0, At, B0); PG8_BAR; PG8_SCHED;
            PG8_STAGE(PG8_SB(1, 1), b3 + hstepB, voffB);
            PG8_WAIT_V(6); PG8_BAR; PG8_MMA(1, 1, At, B1); PG8_BAR;
            }
        }
        if (Epi::MID_T >= 0 && seg == 0) {
            if (wr == 0) PG8_BAR;
            E.mid(acc, cur, wr, wc, fr, fq);
            if (wr == 1) PG8_BAR;
        }
        }
        if constexpr (ALIGN_EPI) { if (wr == 0) PG8_BAR; }
        if constexpr (!Epi::AFTER_DRAIN) E(acc, cur, wr, wc, fr, fq);
        if (!has_next) break;
#pragma unroll
        for (int a = 0; a < 2; ++a)
#pragma unroll
            for (int b = 0; b < 2; ++b)
#pragma unroll
                for (int m = 0; m < 4; ++m)
#pragma unroll
                    for (int n = 0; n < 2; ++n) acc[a][b][m][n] = (f32x4){0.f, 0.f, 0.f, 0.f};
        cur = nxt; cA = nA; cB = nB; ++ui;
        if constexpr (ALIGN_EPI) { if (wr == 1) PG8_BAR; }
    }
    PG8_WAIT_V(0);
    if constexpr (!ALIGN_EPI) { if (wr == 0) PG8_BAR; }
    PG8_BAR;
    if constexpr (Epi::AFTER_DRAIN) E.fused(acc, cur, wr, wc, fr, fq, lds, wid, lane);
#undef PG8_SA
#undef PG8_SB
#undef PG8_STAGE
#undef PG8_LDA
#undef PG8_LDB
#undef PG8_MMA
#undef PG8_WAIT_V
#undef PG8_WAIT_L
#undef PG8_BAR
#undef PG8_SCHED
}
}
using pg8::Unit;
typedef f32x4 Acc[2][2][4][2];

struct EpiAct {
    static constexpr bool PERM = true, AFTER_DRAIN = false; static constexpr int MID_T = -1;
    bf16_t* act; float* statv; float* out;
    __device__ __forceinline__ void mid(Acc&, const Unit&, int, int, int, int) const {}
    template <int KIND> __device__ __forceinline__ void run(Acc& acc, const Unit& u, int wr, int wc, int fr, int fq) const {
        const int blk = u.pn >> 2;
        int row0 = u.pm * 256 + wr * 64 + fr, col0 = u.pn * 256 + wc * 32 + 8 * fq; asm volatile("" : "+v"(row0), "+v"(col0));
#pragma unroll
        for (int ai = 0; ai < 2; ++ai)
#pragma unroll
            for (int m = 0; m < 4; ++m) {
                const int row = row0 + ai * 128 + m * 16;
                bf16_t* rowp = act + (size_t)row * DIN + col0;
                float s = 0.f, q = 0.f;
#pragma unroll
                for (int bj = 0; bj < 2; ++bj) {
                    f32x4 v0 = acc[ai][bj][m][0], v1 = acc[ai][bj][m][1];
#pragma unroll
                    for (int j = 0; j < 4; ++j) {
                        if (KIND == 0) { v0[j] = gelu_t(v0[j]); v1[j] = gelu_t(v1[j]); }
                        if (KIND == 1) { v0[j] = v0[j] * sigm(v0[j]); v1[j] = v1[j] * sigm(v1[j]); }
                        if (KIND == 3) { v0[j] = sigm(v0[j]); v1[j] = sigm(v1[j]); }
                    }
                    if (KIND == 0) {
#pragma unroll
                        for (int j = 0; j < 4; ++j) { s += v0[j] + v1[j]; q += v0[j] * v0[j] + v1[j] * v1[j]; }
                    }
                    u32x4 w; w.x = cvt_pk_bf16(v0[0], v0[1]); w.y = cvt_pk_bf16(v0[2], v0[3]); w.z = cvt_pk_bf16(v1[0], v1[1]); w.w = cvt_pk_bf16(v1[2], v1[3]);
                    *(u32x4*)(rowp + bj * 128) = w;
                    if (KIND == 2 && blk == 4) {
                        const int cb = (u.pn & 3) * 256 + wc * 32 + 8 * fq + bj * 128;
                        float* dst = nullptr;
                        if (row < MPR) { const int pos = row & (SEQ - 1); if (pos >= SEQ - 15) dst = out + O_PP + ((size_t)(row >> 11) * 15 + (pos - (SEQ - 15))) * DM + cb; }
                        else if (row < MREAL) dst = out + O_SP + ((size_t)(row - MPR) * 15 + 14) * DM + cb;
                        if (dst) { *(f32x4*)dst = v0; *(f32x4*)(dst + 4) = v1; }
                    }
                }
                if (KIND == 0 && blk == 2) {
                    s += __shfl_xor(s, 16); s += __shfl_xor(s, 32); q += __shfl_xor(q, 16); q += __shfl_xor(q, 32);
                    if (fq == 0) *(f32x2*)(statv + ((size_t)row * 16 + (u.pn & 3) * 4 + wc) * 2) = (f32x2){s, q};
                }
            }
    }
    __device__ __forceinline__ void operator()(Acc& acc, const Unit& u, int wr, int wc, int fr, int fq) const {
        const int blk = u.pn >> 2;
        if (blk == 2) run<0>(acc, u, wr, wc, fr, fq);
        else if (blk == 1) run<1>(acc, u, wr, wc, fr, fq);
        else if (blk == 0 || blk == 3 || blk == 4) run<2>(acc, u, wr, wc, fr, fq);
        else run<3>(acc, u, wr, wc, fr, fq);
    }
};


struct EpiPool {
    static constexpr bool PERM = true, AFTER_DRAIN = false; static constexpr int MID_T = -1;
    bf16_t* act; const float* scale;
    __device__ __forceinline__ void mid(Acc&, const Unit&, int, int, int, int) const {}
    __device__ __forceinline__ void operator()(Acc& acc, const Unit& u, int wr, int wc, int fr, int fq) const {
        int row0 = u.pm * 256 + wr * 64 + fr, col0 = u.pn * 256 + wc * 32 + 8 * fq; asm volatile("" : "+v"(row0), "+v"(col0));
        f32x4 sc[2][2];
#pragma unroll
        for (int bj = 0; bj < 2; ++bj) { sc[bj][0] = *(const f32x4*)(scale + col0 + bj * 128); sc[bj][1] = *(const f32x4*)(scale + col0 + bj * 128 + 4); }
#pragma unroll
        for (int ai = 0; ai < 2; ++ai)
#pragma unroll
            for (int m = 0; m < 4; ++m) {
                bf16_t* rowp = act + (size_t)(row0 + ai * 128 + m * 16) * DIN + C_ZB + col0;
#pragma unroll
                for (int bj = 0; bj < 2; ++bj) {
                    const u32x4 z = *(const u32x4*)(rowp + bj * 128);
                    const f32x4 v0 = acc[ai][bj][m][0] * sc[bj][0], v1 = acc[ai][bj][m][1] * sc[bj][1];
                    u32x4 w;
                    w.x = cvt_pk_bf16(v0[0] * bf_lo(z.x), v0[1] * bf_hi(z.x)); w.y = cvt_pk_bf16(v0[2] * bf_lo(z.y), v0[3] * bf_hi(z.y));
                    w.z = cvt_pk_bf16(v1[0] * bf_lo(z.z), v1[1] * bf_hi(z.z)); w.w = cvt_pk_bf16(v1[2] * bf_lo(z.w), v1[3] * bf_hi(z.w));
                    *(u32x4*)(rowp + bj * 128) = w;
                }
                if (m == 3) asm volatile("" ::: "memory");
            }
    }
};

struct EpiMerge {
    static constexpr bool PERM = true, AFTER_DRAIN = false; static constexpr int MID_T = 16;
    bf16_t* act;
    __device__ __forceinline__ void mid(Acc& acc, const Unit& u, int wr, int wc, int fr, int fq) const {
        int row0 = u.pm * 256 + wr * 64 + fr, col0 = u.pn * 256 + wc * 32 + 8 * fq; asm volatile("" : "+v"(row0), "+v"(col0));
#pragma unroll
        for (int ai = 0; ai < 2; ++ai)
#pragma unroll
            for (int m = 0; m < 4; ++m) {
                const bf16_t* rowp = act + (size_t)(row0 + ai * 128 + m * 16) * DIN + col0;
#pragma unroll
                for (int bj = 0; bj < 2; ++bj) {
                    const u32x4 ga = *(const u32x4*)(rowp + C_GA + bj * 128), gb = *(const u32x4*)(rowp + C_GB + bj * 128);
                    f32x4 r0, r1;
                    r0[0] = bf_lo(ga.x) * __builtin_amdgcn_rcpf(fmaxf(bf_lo(gb.x), 1e-30f)); r0[1] = bf_hi(ga.x) * __builtin_amdgcn_rcpf(fmaxf(bf_hi(gb.x), 1e-30f));
                    r0[2] = bf_lo(ga.y) * __builtin_amdgcn_rcpf(fmaxf(bf_lo(gb.y), 1e-30f)); r0[3] = bf_hi(ga.y) * __builtin_amdgcn_rcpf(fmaxf(bf_hi(gb.y), 1e-30f));
                    r1[0] = bf_lo(ga.z) * __builtin_amdgcn_rcpf(fmaxf(bf_lo(gb.z), 1e-30f)); r1[1] = bf_hi(ga.z) * __builtin_amdgcn_rcpf(fmaxf(bf_hi(gb.z), 1e-30f));
                    r1[2] = bf_lo(ga.w) * __builtin_amdgcn_rcpf(fmaxf(bf_lo(gb.w), 1e-30f)); r1[3] = bf_hi(ga.w) * __builtin_amdgcn_rcpf(fmaxf(bf_hi(gb.w), 1e-30f));
                    acc[ai][bj][m][0] *= r0; acc[ai][bj][m][1] *= r1;
                }
                if (m & 1) asm volatile("" ::: "memory");
            }
    }
    __device__ __forceinline__ void operator()(Acc& acc, const Unit& u, int wr, int wc, int fr, int fq) const {
        int row0 = u.pm * 256 + wr * 64 + fr, col0 = u.pn * 256 + wc * 32 + 8 * fq; asm volatile("" : "+v"(row0), "+v"(col0));
#pragma unroll
        for (int ai = 0; ai < 2; ++ai)
#pragma unroll
            for (int m = 0; m < 4; ++m) {
                bf16_t* rowp = act + (size_t)(row0 + ai * 128 + m * 16) * DIN + col0;
#pragma unroll
                for (int bj = 0; bj < 2; ++bj) {
                    const u32x4 gb = *(const u32x4*)(rowp + C_GB + bj * 128);
                    const f32x4 v0 = acc[ai][bj][m][0], v1 = acc[ai][bj][m][1];
                    u32x4 w;
                    w.x = cvt_pk_bf16(v0[0] * bf_lo(gb.x), v0[1] * bf_hi(gb.x)); w.y = cvt_pk_bf16(v0[2] * bf_lo(gb.y), v0[3] * bf_hi(gb.y));
                    w.z = cvt_pk_bf16(v1[0] * bf_lo(gb.z), v1[1] * bf_hi(gb.z)); w.w = cvt_pk_bf16(v1[2] * bf_lo(gb.w), v1[3] * bf_hi(gb.w));
                    *(u32x4*)(rowp + C_M + bj * 128) = w;
                }
                if (m == 3) asm volatile("" ::: "memory");
            }
    }
};

struct EpiOut {
    static constexpr bool PERM = true, AFTER_DRAIN = false; static constexpr int MID_T = -1;
    bf16_t* act; float* statt;
    __device__ __forceinline__ void mid(Acc&, const Unit&, int, int, int, int) const {}
    __device__ __forceinline__ void operator()(Acc& acc, const Unit& u, int wr, int wc, int fr, int fq) const {
        int row0 = u.pm * 256 + wr * 64 + fr, col0 = u.pn * 256 + wc * 32 + 8 * fq; asm volatile("" : "+v"(row0), "+v"(col0));
#pragma unroll
        for (int ai = 0; ai < 2; ++ai)
#pragma unroll
            for (int m = 0; m < 4; ++m) {
                const int row = row0 + ai * 128 + m * 16;
                bf16_t* rowp = act + (size_t)row * DIN + C_T + col0;
                float q = 0.f;
#pragma unroll
                for (int bj = 0; bj < 2; ++bj) {
                    const f32x4 v0 = acc[ai][bj][m][0], v1 = acc[ai][bj][m][1];
                    q += (v0[0] * v0[0] + v0[1] * v0[1]) + (v0[2] * v0[2] + v0[3] * v0[3]) + (v1[0] * v1[0] + v1[1] * v1[1]) + (v1[2] * v1[2] + v1[3] * v1[3]);
                    u32x4 w; w.x = cvt_pk_bf16(v0[0], v0[1]); w.y = cvt_pk_bf16(v0[2], v0[3]); w.z = cvt_pk_bf16(v1[0], v1[1]); w.w = cvt_pk_bf16(v1[2], v1[3]);
                    *(u32x4*)(rowp + bj * 128) = w;
                }
                q += __shfl_xor(q, 16); q += __shfl_xor(q, 32);
                if (fq == 0) statt[(size_t)row * 16 + u.pn * 4 + wc] = q;
            }
    }
};

struct EpiGate {
    static constexpr bool PERM = true, AFTER_DRAIN = false; static constexpr int MID_T = 4;
    bf16_t* act; float* statg;
    __device__ __forceinline__ void mid(Acc& acc, const Unit& u, int wr, int wc, int fr, int fq) const {
        int row0 = u.pm * 256 + wr * 64 + fr, col0 = u.pn * 256 + wc * 32 + 8 * fq; asm volatile("" : "+v"(row0), "+v"(col0));
#pragma unroll
        for (int ai = 0; ai < 2; ++ai)
#pragma unroll
            for (int m = 0; m < 4; ++m) {
                bf16_t* rowp = act + (size_t)(row0 + ai * 128 + m * 16) * DIN + C_E + col0;
#pragma unroll
                for (int bj = 0; bj < 2; ++bj) {
                    const f32x4 v0 = acc[ai][bj][m][0], v1 = acc[ai][bj][m][1];
                    u32x4 w; w.x = cvt_pk_bf16(v0[0], v0[1]); w.y = cvt_pk_bf16(v0[2], v0[3]); w.z = cvt_pk_bf16(v1[0], v1[1]); w.w = cvt_pk_bf16(v1[2], v1[3]);
                    *(u32x4*)(rowp + bj * 128) = w;
                    acc[ai][bj][m][0] = (f32x4){0.f, 0.f, 0.f, 0.f}; acc[ai][bj][m][1] = (f32x4){0.f, 0.f, 0.f, 0.f};
                }
            }
    }
    __device__ __forceinline__ void operator()(Acc& acc, const Unit& u, int wr, int wc, int fr, int fq) const {
        int row0 = u.pm * 256 + wr * 64 + fr, col0 = u.pn * 256 + wc * 32 + 8 * fq; asm volatile("" : "+v"(row0), "+v"(col0));
#pragma unroll
        for (int ai = 0; ai < 2; ++ai)
#pragma unroll
            for (int m = 0; m < 4; ++m) {
                const int row = row0 + ai * 128 + m * 16;
                const bf16_t* erow = act + (size_t)row * DIN + C_E + col0;
                bf16_t* grow = act + (size_t)row * DIN + C_GE + col0;
                float q = 0.f;
#pragma unroll
                for (int bj = 0; bj < 2; ++bj) {
                    const u32x4 e = *(const u32x4*)(erow + bj * 128);
                    const f32x4 a0 = acc[ai][bj][m][0], a1 = acc[ai][bj][m][1];
                    f32x4 v0, v1;
                    v0[0] = sigm(a0[0]) * bf_lo(e.x); v0[1] = sigm(a0[1]) * bf_hi(e.x); v0[2] = sigm(a0[2]) * bf_lo(e.y); v0[3] = sigm(a0[3]) * bf_hi(e.y);
                    v1[0] = sigm(a1[0]) * bf_lo(e.z); v1[1] = sigm(a1[1]) * bf_hi(e.z); v1[2] = sigm(a1[2]) * bf_lo(e.w); v1[3] = sigm(a1[3]) * bf_hi(e.w);
#pragma unroll
                    for (int j = 0; j < 4; ++j) q += v0[j] * v0[j] + v1[j] * v1[j];
                    u32x4 w; w.x = cvt_pk_bf16(v0[0], v0[1]); w.y = cvt_pk_bf16(v0[2], v0[3]); w.z = cvt_pk_bf16(v1[0], v1[1]); w.w = cvt_pk_bf16(v1[2], v1[3]);
                    *(u32x4*)(grow + bj * 128) = w;
                }
                q += __shfl_xor(q, 16); q += __shfl_xor(q, 32);
                if (fq == 0) statg[(size_t)row * 16 + u.pn * 4 + wc] = q;
                asm volatile("" ::: "memory");
            }
    }
};


struct RowX {
    float* xbuf; unsigned* cnt;
    __device__ __forceinline__ void put(int k, float q, int wr, int wc, int fr, int fq, LAS unsigned char* lds) const {
        LAS float* P = (LAS float*)lds;
        q += __shfl_xor(q, 16); q += __shfl_xor(q, 32);
        if (fq == 0) P[((k >> 2) * 128 + wr * 64 + (k & 3) * 16 + fr) * 4 + wc] = q;
    }
    __device__ __forceinline__ void exchange(const Unit& u, LAS unsigned char* lds, int wid, int lane) const {
        LAS float* P = (LAS float*)lds; LAS float* S = (LAS float*)(lds + 4096);
        asm volatile("s_waitcnt lgkmcnt(0)" ::: "memory"); __builtin_amdgcn_s_barrier(); asm volatile("" ::: "memory");
        const int row = wid * 32 + (lane & 31);
        if (lane < 32) {
            const float t = (P[row * 4] + P[row * 4 + 1]) + (P[row * 4 + 2] + P[row * 4 + 3]);
            __hip_atomic_store(xbuf + ((size_t)(u.pm * 256 + row) * 4 + u.pn), t, __ATOMIC_RELAXED, __HIP_MEMORY_SCOPE_AGENT);
        }
        asm volatile("s_waitcnt vmcnt(0)" ::: "memory");
        if (lane == 0) __hip_atomic_fetch_add(cnt + 64 * u.pm, 1u, __ATOMIC_RELAXED, __HIP_MEMORY_SCOPE_AGENT);
        if (wid == 0) {
            unsigned sp = 0;
            while ((unsigned)__builtin_amdgcn_readfirstlane(__hip_atomic_load(cnt + 64 * u.pm, __ATOMIC_RELAXED, __HIP_MEMORY_SCOPE_AGENT)) < 32u) { __builtin_amdgcn_s_sleep(2); if (++sp > (1u << 22)) break; }
            __builtin_amdgcn_fence(__ATOMIC_ACQUIRE, "agent");
        }
        asm volatile("s_waitcnt vmcnt(0) lgkmcnt(0)" ::: "memory"); __builtin_amdgcn_s_barrier(); asm volatile("" ::: "memory");
        if (lane < 32) {
            float* slot = xbuf + (size_t)(u.pm * 256 + row) * 4; float s = 0.f;
#pragma unroll
            for (int t = 0; t < 4; ++t) s += __hip_atomic_load(slot + t, __ATOMIC_RELAXED, __HIP_MEMORY_SCOPE_AGENT);
            S[row] = 1.0f / sqrtf(s * (1.0f / DM) + EPS);
        }
        asm volatile("s_waitcnt lgkmcnt(0)" ::: "memory"); __builtin_amdgcn_s_barrier(); asm volatile("" ::: "memory");
    }
};
struct EpiOutF {
    static constexpr bool PERM = true, AFTER_DRAIN = true; static constexpr int MID_T = -1;
    bf16_t* act; const float* x; float* rstd1g; const float* post_g; const float* ple_in_g; RowX X1, X2;
    __device__ __forceinline__ void mid(Acc&, const Unit&, int, int, int, int) const {}
    __device__ __forceinline__ void operator()(Acc&, const Unit&, int, int, int, int) const {}
    __device__ __forceinline__ void fused(Acc& acc, const Unit& u, int wr, int wc, int fr, int fq, LAS unsigned char* lds, int wid, int lane) const {
        int row0 = u.pm * 256 + wr * 64 + fr, col0 = u.pn * 256 + wc * 32 + 8 * fq; asm volatile("" : "+v"(row0), "+v"(col0));
        const LAS float* S = (const LAS float*)(lds + 4096);
#pragma unroll
        for (int k = 0; k < 8; ++k) { float q = 0.f;
#pragma unroll
            for (int bj = 0; bj < 2; ++bj)
#pragma unroll
                for (int n = 0; n < 2; ++n) { const f32x4 v = acc[k >> 2][bj][k & 3][n]; q += (v[0] * v[0] + v[1] * v[1]) + (v[2] * v[2] + v[3] * v[3]); }
            X1.put(k, q, wr, wc, fr, fq, lds); }
        X1.exchange(u, lds, wid, lane);
#pragma unroll
        for (int k = 0; k < 8; ++k) {
            const int ai = k >> 2, m = k & 3, rl = ai * 128 + wr * 64 + m * 16 + fr; const float rstd = S[rl];
            const unsigned off = (unsigned)((row0 + ai * 128 + m * 16) * DM + col0) * 4u; float q = 0.f;
#pragma unroll
            for (int bj = 0; bj < 2; ++bj)
#pragma unroll
                for (int n = 0; n < 2; ++n) {
                    const f32x4 hv = *(const f32x4*)((const char*)x + off + (bj * 128 + 4 * n) * 4), gv = *(const f32x4*)(post_g + col0 + bj * 128 + 4 * n);
                    const f32x4 h1 = hv + acc[ai][bj][m][n] * rstd * gv;
                    acc[ai][bj][m][n] = h1; q += (h1[0] * h1[0] + h1[1] * h1[1]) + (h1[2] * h1[2] + h1[3] * h1[3]);
                }
            X2.put(k, q, wr, wc, fr, fq, lds + 8192);
            asm volatile("" : "+v"(acc[ai][0][m][0]), "+v"(acc[ai][0][m][1]), "+v"(acc[ai][1][m][0]), "+v"(acc[ai][1][m][1]));
            if (k & 1) asm volatile("" ::: "memory");
        }
        X2.exchange(u, lds + 8192, wid, lane);
        const LAS float* S2 = (const LAS float*)(lds + 8192 + 4096);
        if (u.pn == 0 && lane < 32) rstd1g[u.pm * 256 + wid * 32 + lane] = S2[wid * 32 + lane];
#pragma unroll
        for (int k = 0; k < 8; ++k) {
            const int ai = k >> 2, m = k & 3, rl = ai * 128 + wr * 64 + m * 16 + fr; const float rstd1 = S2[rl];
            const unsigned off = (unsigned)((row0 + ai * 128 + m * 16) * DIN + PLE + col0) * 2u;
#pragma unroll
            for (int bj = 0; bj < 2; ++bj) {
                const f32x4 g0 = *(const f32x4*)(ple_in_g + col0 + bj * 128), g1 = *(const f32x4*)(ple_in_g + col0 + bj * 128 + 4);
                const f32x4 v0 = acc[ai][bj][m][0] * rstd1 * g0, v1 = acc[ai][bj][m][1] * rstd1 * g1;
                u32x4 w; w.x = cvt_pk_bf16(v0[0], v0[1]); w.y = cvt_pk_bf16(v0[2], v0[3]); w.z = cvt_pk_bf16(v1[0], v1[1]); w.w = cvt_pk_bf16(v1[2], v1[3]);
                *(u32x4*)((char*)act + off + bj * 256) = w;
            }
            if ((k & 3) == 3) asm volatile("" ::: "memory");
        }
    }
};
struct EpiGateF {
    static constexpr bool PERM = true, AFTER_DRAIN = true; static constexpr int MID_T = 4;
    bf16_t* act; float* out; const float* g; const float* gin; const float* rstd1g; RowX X;
    __device__ __forceinline__ void operator()(Acc&, const Unit&, int, int, int, int) const {}
    __device__ __forceinline__ void mid(Acc& acc, const Unit& u, int wr, int wc, int fr, int fq) const {
        int row0 = u.pm * 256 + wr * 64 + fr, col0 = u.pn * 256 + wc * 32 + 8 * fq; asm volatile("" : "+v"(row0), "+v"(col0));
#pragma unroll
        for (int ai = 0; ai < 2; ++ai)
#pragma unroll
            for (int m = 0; m < 4; ++m) {
                bf16_t* rowp = act + (size_t)(row0 + ai * 128 + m * 16) * DIN + C_E + col0;
#pragma unroll
                for (int bj = 0; bj < 2; ++bj) {
                    const f32x4 v0 = acc[ai][bj][m][0], v1 = acc[ai][bj][m][1];
                    u32x4 w; w.x = cvt_pk_bf16(v0[0], v0[1]); w.y = cvt_pk_bf16(v0[2], v0[3]); w.z = cvt_pk_bf16(v1[0], v1[1]); w.w = cvt_pk_bf16(v1[2], v1[3]);
                    *(u32x4*)(rowp + bj * 128) = w;
                    acc[ai][bj][m][0] = (f32x4){0.f, 0.f, 0.f, 0.f}; acc[ai][bj][m][1] = (f32x4){0.f, 0.f, 0.f, 0.f};
                }
            }
    }
    __device__ __forceinline__ void fused(Acc& acc, const Unit& u, int wr, int wc, int fr, int fq, LAS unsigned char* lds, int wid, int lane) const {
        int row0 = u.pm * 256 + wr * 64 + fr, col0 = u.pn * 256 + wc * 32 + 8 * fq; asm volatile("" : "+v"(row0), "+v"(col0));
        const LAS float* S = (const LAS float*)(lds + 4096);
#pragma unroll
        for (int k = 0; k < 8; ++k) {
            const int ai = k >> 2, m = k & 3;
            const unsigned eoff = (unsigned)((row0 + ai * 128 + m * 16) * DIN + C_E + col0) * 2u; float q = 0.f;
#pragma unroll
            for (int bj = 0; bj < 2; ++bj) {
                const u32x4 e = *(const u32x4*)((const char*)act + eoff + bj * 256);
                const f32x4 a0 = acc[ai][bj][m][0], a1 = acc[ai][bj][m][1];
                f32x4 v0, v1;
                v0[0] = sigm(a0[0]) * bf_lo(e.x); v0[1] = sigm(a0[1]) * bf_hi(e.x); v0[2] = sigm(a0[2]) * bf_lo(e.y); v0[3] = sigm(a0[3]) * bf_hi(e.y);
                v1[0] = sigm(a1[0]) * bf_lo(e.z); v1[1] = sigm(a1[1]) * bf_hi(e.z); v1[2] = sigm(a1[2]) * bf_lo(e.w); v1[3] = sigm(a1[3]) * bf_hi(e.w);
#pragma unroll
                for (int j = 0; j < 4; ++j) q += v0[j] * v0[j] + v1[j] * v1[j];
                acc[ai][bj][m][0] = v0; acc[ai][bj][m][1] = v1;
            }
            X.put(k, q, wr, wc, fr, fq, lds);
            asm volatile("" : "+v"(acc[ai][0][m][0]), "+v"(acc[ai][0][m][1]), "+v"(acc[ai][1][m][0]), "+v"(acc[ai][1][m][1]));
            if (k & 1) asm volatile("" ::: "memory");
        }
        X.exchange(u, lds, wid, lane);
        f32x4 ig[2][2];
#pragma unroll
        for (int bj = 0; bj < 2; ++bj)
#pragma unroll
            for (int n = 0; n < 2; ++n) { const f32x4 gi = *(const f32x4*)(gin + col0 + bj * 128 + 4 * n);
                ig[bj][n] = (f32x4){__builtin_amdgcn_rcpf(gi[0]), __builtin_amdgcn_rcpf(gi[1]), __builtin_amdgcn_rcpf(gi[2]), __builtin_amdgcn_rcpf(gi[3])}; }
#pragma unroll
        for (int k = 0; k < 8; ++k) {
            const int ai = k >> 2, m = k & 3, rl = ai * 128 + wr * 64 + m * 16 + fr; const float rstd = S[rl];
            const int row = row0 + ai * 128 + m * 16;
            const float ir1 = __builtin_amdgcn_rcpf(rstd1g[row]);
            const unsigned off = (unsigned)(row * DM + col0) * 4u, hoff = (unsigned)(row * DIN + PLE + col0) * 2u;
#pragma unroll
            for (int bj = 0; bj < 2; ++bj) {
                const u32x4 hn = *(const u32x4*)((const char*)act + hoff + bj * 256);
                const f32x4 h0 = (f32x4){bf_lo(hn.x), bf_hi(hn.x), bf_lo(hn.y), bf_hi(hn.y)} * ig[bj][0] * ir1, h1v = (f32x4){bf_lo(hn.z), bf_hi(hn.z), bf_lo(hn.w), bf_hi(hn.w)} * ig[bj][1] * ir1;
                const f32x4 g0 = *(const f32x4*)(g + col0 + bj * 128), g1 = *(const f32x4*)(g + col0 + bj * 128 + 4);
                *(f32x4*)((char*)out + off + (bj * 128) * 4) = h0 + acc[ai][bj][m][0] * rstd * g0;
                *(f32x4*)((char*)out + off + (bj * 128 + 4) * 4) = h1v + acc[ai][bj][m][1] * rstd * g1;
            }
            if (k & 1) asm volatile("" ::: "memory");
        }
    }
};

template <int NT>
__device__ __forceinline__ void small_gemm1(const Params& p, const bf16_t* A, int lda, const bf16_t* Bt, int ldb, int K, int nstrips) {
    const int tid = threadIdx.x, lane = tid & 63, wid = __builtin_amdgcn_readfirstlane(tid >> 6), fr = lane & 15, fq = lane >> 4;
    bf16_t* act = (bf16_t*)(p.ws + WS_ACT);
    for (int u = blockIdx.x; u < nstrips; u += gridDim.x) {
        const int n0 = u * 16 * NT, r = wid * 16 + fr, row = MPR + r;
        const bf16_t* ap = A + (size_t)row * lda + 8 * fq;
        const bf16_t* bp = Bt + (size_t)(n0 + fr) * ldb + 8 * fq;
        bf16_t* arow = act + (size_t)row * DIN;
        f32x4 acc[NT];
#pragma unroll
        for (int t = 0; t < NT; ++t) acc[t] = (f32x4){0.f, 0.f, 0.f, 0.f};
        for (int k0 = 0; k0 < K; k0 += 256) {
            bf16x8 a[8], b[NT][8];
#pragma unroll
            for (int j = 0; j < 8; ++j) { a[j] = *(const bf16x8*)(ap + k0 + 32 * j);
#pragma unroll
                for (int t = 0; t < NT; ++t) b[t][j] = *(const bf16x8*)(bp + (size_t)t * 16 * ldb + k0 + 32 * j); }
#pragma unroll
            for (int j = 0; j < 8; ++j)
#pragma unroll
                for (int t = 0; t < NT; ++t) acc[t] = __builtin_amdgcn_mfma_f32_16x16x32_bf16(b[t][j], a[j], acc[t], 0, 0, 0);
        }
#pragma unroll
        for (int t = 0; t < NT; ++t) {
            const int nt0 = n0 + 16 * t, col = nt0 + 4 * fq, blk = nt0 >> 10; f32x4 v = acc[t];
            if (blk == 2) { v[0] = gelu_t(v[0]); v[1] = gelu_t(v[1]); v[2] = gelu_t(v[2]); v[3] = gelu_t(v[3]); }
            else if (blk == 1) { v[0] *= sigm(v[0]); v[1] *= sigm(v[1]); v[2] *= sigm(v[2]); v[3] *= sigm(v[3]); }
            else if (blk >= 5) { v[0] = sigm(v[0]); v[1] = sigm(v[1]); v[2] = sigm(v[2]); v[3] = sigm(v[3]); }
            u32x2 w; w.x = cvt_pk_bf16(v[0], v[1]); w.y = cvt_pk_bf16(v[2], v[3]);
            *(u32x2*)(arow + col) = w;
            if (blk == 2) {
                float s = (v[0] + v[1]) + (v[2] + v[3]), q = (v[0] * v[0] + v[1] * v[1]) + (v[2] * v[2] + v[3] * v[3]);
                s += __shfl_xor(s, 16); s += __shfl_xor(s, 32); q += __shfl_xor(q, 16); q += __shfl_xor(q, 32);
                if (fq == 0) *(f32x2*)((float*)(p.ws + WS_SVS) + ((size_t)r * 64 + ((nt0 & 1023) >> 4)) * 2) = (f32x2){s, q};
            }
            if (blk == 4) *(f32x4*)(p.out + O_SP + ((size_t)r * 15 + 14) * DM + (col & 1023)) = v;
        }
    }
}

template <int MODE>
__device__ __forceinline__ void small2(LAS unsigned char* lds, const Params& p, const bf16_t* A, int lda, const bf16_t* Bt, int ldb) {
    const int tid = threadIdx.x, lane = tid & 63, wid = __builtin_amdgcn_readfirstlane(tid >> 6), fr = lane & 15, fq = lane >> 4, rt = wid & 1, kq = wid >> 1;
    bf16_t* act = (bf16_t*)(p.ws + WS_ACT);
    LAS f32x4* red = (LAS f32x4*)lds;
    for (int u = blockIdx.x; u < 256; u += gridDim.x) {
        const int strip = u & 63, n0 = strip * 16, r = (u >> 6) * 32 + rt * 16 + fr, row = MPR + r, col = n0 + 4 * fq;
        const bf16_t* ap = A + (size_t)row * lda + 8 * fq + (MODE == 2 ? (n0 >> 8) * 256 : 0);
        const bf16_t* bp = Bt + (size_t)(n0 + fr) * ldb + 8 * fq;
        bf16_t* arow = act + (size_t)row * DIN;
        f32x4 acc = (f32x4){0.f, 0.f, 0.f, 0.f}, e4 = (f32x4){0.f, 0.f, 0.f, 0.f};
        if (MODE == 2) {
            bf16x8 a[2], b[2];
#pragma unroll
            for (int j = 0; j < 2; ++j) { a[j] = *(const bf16x8*)(ap + kq * 64 + 32 * j); b[j] = *(const bf16x8*)(bp + kq * 64 + 32 * j); }
#pragma unroll
            for (int j = 0; j < 2; ++j) acc = __builtin_amdgcn_mfma_f32_16x16x32_bf16(b[j], a[j], acc, 0, 0, 0);
        } else {
            constexpr int NB = MODE == 3 ? 2 : 1;
            const int kbase = MODE == 3 ? kq * 512 : MODE == 4 ? kq * 256 : 256 + kq * 256;
            if (MODE == 6 && kq == 0) {
                bf16x8 a[8], b[8];
#pragma unroll
                for (int j = 0; j < 8; ++j) { a[j] = *(const bf16x8*)(ap + 32 * j); b[j] = *(const bf16x8*)(bp + 32 * j); }
#pragma unroll
                for (int j = 0; j < 8; ++j) e4 = __builtin_amdgcn_mfma_f32_16x16x32_bf16(b[j], a[j], e4, 0, 0, 0);
            }
#pragma unroll
            for (int bt = 0; bt < NB; ++bt) {
                bf16x8 a[8], b[8];
#pragma unroll
                for (int j = 0; j < 8; ++j) { a[j] = *(const bf16x8*)(ap + kbase + bt * 256 + 32 * j); b[j] = *(const bf16x8*)(bp + kbase + bt * 256 + 32 * j); }
#pragma unroll
                for (int j = 0; j < 8; ++j) acc = __builtin_amdgcn_mfma_f32_16x16x32_bf16(b[j], a[j], acc, 0, 0, 0);
            }
        }
        red[wid * 64 + lane] = acc;
        __syncthreads();
        if (kq == 0) {
            const f32x4 p1 = red[(rt + 2) * 64 + lane], p2 = red[(rt + 4) * 64 + lane], p3 = red[(rt + 6) * 64 + lane];
            f32x4 v;
            if (MODE == 3) {
                const u32x2 ga = *(const u32x2*)(arow + C_GA + col), gb = *(const u32x2*)(arow + C_GB + col);
                const f32x4 ya = acc + p1, yb = p2 + p3;
                v[0] = ya[0] * bf_lo(ga.x) + yb[0] * bf_lo(gb.x); v[1] = ya[1] * bf_hi(ga.x) + yb[1] * bf_hi(gb.x);
                v[2] = ya[2] * bf_lo(ga.y) + yb[2] * bf_lo(gb.y); v[3] = ya[3] * bf_hi(ga.y) + yb[3] * bf_hi(gb.y);
                u32x2 w; w.x = cvt_pk_bf16(v[0], v[1]); w.y = cvt_pk_bf16(v[2], v[3]);
                *(u32x2*)(arow + C_M + col) = w;
            } else {
                v = (acc + p1) + (p2 + p3);
                if (MODE == 2) {
                    const u32x2 z = *(const u32x2*)(arow + C_ZB + col); const f32x4 sc = *(const f32x4*)(p.pool_scale + col);
                    u32x2 w; w.x = cvt_pk_bf16(v[0] * sc[0] * bf_lo(z.x), v[1] * sc[1] * bf_hi(z.x)); w.y = cvt_pk_bf16(v[2] * sc[2] * bf_lo(z.y), v[3] * sc[3] * bf_hi(z.y));
                    *(u32x2*)(arow + C_ZB + col) = w;
                } else {
                    if (MODE == 6) { v[0] = sigm(v[0]) * e4[0]; v[1] = sigm(v[1]) * e4[1]; v[2] = sigm(v[2]) * e4[2]; v[3] = sigm(v[3]) * e4[3]; }
                    { u32x2 w; w.x = cvt_pk_bf16(v[0], v[1]); w.y = cvt_pk_bf16(v[2], v[3]); *(u32x2*)(arow + (MODE == 4 ? C_T : C_GE) + col) = w; }
                    float q = (v[0] * v[0] + v[1] * v[1]) + (v[2] * v[2] + v[3] * v[3]);
                    q += __shfl_xor(q, 16); q += __shfl_xor(q, 32);
                    if (fq == 0) ((float*)(p.ws + (MODE == 4 ? WS_STS : WS_SGS)))[(size_t)r * 64 + strip] = q;
                }
            }
        }
        __syncthreads();
    }
}

template <int MODE> struct PreSmall2 {
    LAS unsigned char* lds; const Params& p; const bf16_t* A; int lda; const bf16_t* Bt; int ldb;
    __device__ __forceinline__ void operator()() const { small2<MODE>(lds + 131072 + 64, p, A, lda, Bt, ldb); }
};

__device__ __forceinline__ void transpose_tile(LAS unsigned char* lds, const float* src, int lds_src, int k0, int n0, bf16_t* dst, int ldd, int drow0, int dcol0) {
    LAS bf16_t* T = (LAS bf16_t*)lds;
    const int tid = threadIdx.x;
#pragma unroll
    for (int i = 0; i < 2; ++i) {
        const int r = (tid >> 4) + 32 * i, c4 = (tid & 15) * 4;
        const f32x4 v = *(const f32x4*)(src + (size_t)(k0 + r) * lds_src + n0 + c4);
        const unsigned p01 = cvt_pk_bf16(v[0], v[1]), p23 = cvt_pk_bf16(v[2], v[3]);
        T[(c4 + 0) * 72 + r] = (bf16_t)(p01 & 0xffffu); T[(c4 + 1) * 72 + r] = (bf16_t)(p01 >> 16);
        T[(c4 + 2) * 72 + r] = (bf16_t)(p23 & 0xffffu); T[(c4 + 3) * 72 + r] = (bf16_t)(p23 >> 16);
    }
    __syncthreads();
    {
        const int n = tid >> 3, kc = (tid & 7) * 8;
        const u32x4 w = *(const LAS u32x4*)(T + n * 72 + kc);
        *(u32x4*)(dst + (size_t)(drow0 + n) * ldd + dcol0 + kc) = w;
    }
    __syncthreads();
}

__device__ __forceinline__ void phase_prep(LAS unsigned char* lds, const Params& p) {
    const int tid = threadIdx.x, lane = tid & 63, wid = tid >> 6, G = gridDim.x, bid = blockIdx.x;
    bf16_t* XN = (bf16_t*)((unsigned char*)p.out + DO_XN);
    bf16_t* WinT = (bf16_t*)((unsigned char*)p.out + DO_WIN);
    bf16_t* WcatT = (bf16_t*)(p.ws + WS_WCAT); bf16_t* WoutT = (bf16_t*)(p.ws + WS_WOUT); bf16_t* W6T = (bf16_t*)(p.ws + WS_W6);
    bf16_t* WpoolT = (bf16_t*)(p.ws + WS_WPOOL); bf16_t* WsB = (bf16_t*)(p.ws + WS_WS);
    for (int row = bid * 8 + wid; row < MREAL; row += G * 8) {
        bf16_t* dst = XN + (size_t)row * DM;
        const float* src = row < MPR ? p.x_prompt + (size_t)row * DM : p.x_sample + (size_t)(row - MPR) * DM;
        f32x4 v[4]; float ss = 0.f;
#pragma unroll
        for (int i = 0; i < 4; ++i) { v[i] = *(const f32x4*)(src + lane * 4 + 256 * i); ss += (v[i][0] * v[i][0] + v[i][1] * v[i][1]) + (v[i][2] * v[i][2] + v[i][3] * v[i][3]); }
        ss = wave_sum(ss);
        const float rstd = 1.0f / sqrtf(ss * (1.0f / DM) + EPS);
#pragma unroll
        for (int i = 0; i < 4; ++i) {
            const f32x4 g = *(const f32x4*)(p.pre_g + lane * 4 + 256 * i);
            u32x2 w; w.x = cvt_pk_bf16(v[i][0] * rstd * g[0], v[i][1] * rstd * g[1]); w.y = cvt_pk_bf16(v[i][2] * rstd * g[2], v[i][3] * rstd * g[3]);
            *(u32x2*)(dst + lane * 4 + 256 * i) = w;
        }
    }
    constexpr int T_IN = 16 * 112, T_SQ = 256, T_PLE = 64, T_POOL = 64, T_ALL = T_IN + 4 * T_SQ + T_PLE + T_POOL;
    for (int it = bid; it < T_ALL; it += G) {
        int r = it;
        if (r < T_IN) {
            const int kt = r / 112, ntile = r % 112, n0 = ntile * 64, sb = n0 >> 10;
            const int db = sb == 0 ? 0 : sb == 1 ? 2 : sb == 2 ? 3 : sb == 3 ? 4 : sb == 4 ? 1 : sb;
            transpose_tile(lds, p.w_in, DIN, kt * 64, n0, WinT, DM, db * 1024 + (n0 & 1023), kt * 64); continue; }
        r -= T_IN;
        if (r < T_SQ) { transpose_tile(lds, p.w_pa, DM, (r >> 4) * 64, (r & 15) * 64, WcatT, 2048, (r & 15) * 64, (r >> 4) * 64); continue; } r -= T_SQ;
        if (r < T_SQ) { transpose_tile(lds, p.w_pb, DM, (r >> 4) * 64, (r & 15) * 64, WcatT, 2048, (r & 15) * 64, 1024 + (r >> 4) * 64); continue; } r -= T_SQ;
        if (r < T_SQ) { transpose_tile(lds, p.w_out, DM, (r >> 4) * 64, (r & 15) * 64, WoutT, 1024, (r & 15) * 64, (r >> 4) * 64); continue; } r -= T_SQ;
        if (r < T_SQ) { transpose_tile(lds, p.w_pg, DM, (r >> 4) * 64, (r & 15) * 64, W6T, 1280, (r & 15) * 64, 256 + (r >> 4) * 64); continue; } r -= T_SQ;
        if (r < T_PLE) { transpose_tile(lds, p.w_ple, DM, (r >> 4) * 64, (r & 15) * 64, W6T, 1280, (r & 15) * 64, (r >> 4) * 64); continue; } r -= T_PLE;
        { const int g = r >> 4, q = r & 15; transpose_tile(lds, p.w_pool + (size_t)g * 65536, 256, (q >> 2) * 64, (q & 3) * 64, WpoolT + (size_t)g * 65536, 256, (q & 3) * 64, (q >> 2) * 64); }
    }
    const int nb2 = (G == 256) ? 128 : G, b2 = (G == 256) ? bid - 128 : bid;
    if (b2 >= 0) for (int i = b2 * NTHR + tid; i < 8 * 128 * 128 / 4; i += nb2 * NTHR) {
        const int e = i * 4, t = (e >> 7) & 127, s = e & 127;
        const f32x4 v = *(const f32x4*)(p.w_s + e);
        u32x2 w; w.x = cvt_pk_bf16(s + 0 <= t ? v[0] : 0.f, s + 1 <= t ? v[1] : 0.f); w.y = cvt_pk_bf16(s + 2 <= t ? v[2] : 0.f, s + 3 <= t ? v[3] : 0.f);
        *(u32x2*)(WsB + e) = w;
    }
    if (b2 >= 0) for (int i = b2 * NTHR + tid; i < MSM * 14 * DM / 4; i += nb2 * NTHR) {
        const int e = i * 4, b = e / (14 * DM), rem = e % (14 * DM);
        *(f32x4*)(p.out + O_SP + (size_t)b * 15 * DM + rem) = *(const f32x4*)(p.state_pool + (size_t)b * 15 * DM + DM + rem);
    }
}

__device__ __forceinline__ void mix_unit(LAS unsigned char* lds, const Params& p, int c, int h, bool load_w) {
    const int tid = threadIdx.x, lane = tid & 63, wid = __builtin_amdgcn_readfirstlane(tid >> 6), fr = lane & 15, fq = lane >> 4;
    bf16_t* act = (bf16_t*)(p.ws + WS_ACT);
    const float* statv = (const float*)(p.ws + WS_STATV);
    const bf16_t* WsB = (const bf16_t*)(p.ws + WS_WS);
    constexpr int SW = 136, SV = 136;
    LAS bf16_t* Wt = (LAS bf16_t*)lds;
    LAS bf16_t* Vt = (LAS bf16_t*)(lds + 128 * SW * 2);
    LAS float* St = (LAS float*)(lds + 128 * SW * 2 + 128 * SV * 2);
    const int R0 = c * 128, C0 = h * 128, wt = wid >> 1, wd = wid & 1;
    u32x4 wreg[4];
    if (load_w) {
#pragma unroll
        for (int i = 0; i < 4; ++i) { const int idx = tid + i * NTHR, t = idx >> 4, sc = idx & 15; wreg[i] = *(const u32x4*)(WsB + ((size_t)h * 128 + t) * 128 + sc * 8); }
    }
    const f32x4 sv0 = *(const f32x4*)(statv + (size_t)(R0 + (tid >> 2)) * 32 + (tid & 3) * 8), sv1 = *(const f32x4*)(statv + (size_t)(R0 + (tid >> 2)) * 32 + (tid & 3) * 8 + 4);
    u32x4 ra[2], rb[2]; f32x4 lg0[2], lg1[2], lb0[2], lb1[2];
#pragma unroll
    for (int i = 0; i < 2; ++i) {
        const int idx = tid + i * NTHR, sp2 = idx & 63, dc = idx >> 6, s0 = sp2 * 2, d0 = dc * 8;
        ra[i] = *(const u32x4*)(act + (size_t)(R0 + s0) * DIN + C_V + C0 + d0); rb[i] = *(const u32x4*)(act + (size_t)(R0 + s0 + 1) * DIN + C_V + C0 + d0);
        lg0[i] = *(const f32x4*)(p.ln_g + C0 + d0); lg1[i] = *(const f32x4*)(p.ln_g + C0 + d0 + 4); lb0[i] = *(const f32x4*)(p.ln_b + C0 + d0); lb1[i] = *(const f32x4*)(p.ln_b + C0 + d0 + 4);
    }
    u32x2 uu[2][4], za[2][4]; float bs[2];
#pragma unroll
    for (int i = 0; i < 2; ++i) {
        const int t = 32 * wt + 16 * i + fr; bs[i] = p.b_s[h * 128 + t];
        const bf16_t* rowp = act + (size_t)(R0 + t) * DIN + C0 + 64 * wd + 4 * fq;
#pragma unroll
        for (int j = 0; j < 4; ++j) { uu[i][j] = *(const u32x2*)(rowp + C_U + 16 * j); za[i][j] = *(const u32x2*)(rowp + C_ZA + 16 * j); }
    }
    if (load_w) {
#pragma unroll
        for (int i = 0; i < 4; ++i) { const int idx = tid + i * NTHR, t = idx >> 4, sc = idx & 15; *(LAS u32x4*)(Wt + t * SW + sc * 8) = wreg[i]; }
    }
    {
        float s = (sv0[0] + sv0[2]) + (sv1[0] + sv1[2]), q = (sv0[1] + sv0[3]) + (sv1[1] + sv1[3]);
        s += __shfl_xor(s, 1); q += __shfl_xor(q, 1); s += __shfl_xor(s, 2); q += __shfl_xor(q, 2);
        if ((tid & 3) == 0) { const float mean = s * (1.0f / DM), var = fmaxf(q * (1.0f / DM) - mean * mean, 0.f); St[(tid >> 2) * 2] = mean; St[(tid >> 2) * 2 + 1] = 1.0f / sqrtf(var + EPS); }
    }
    __syncthreads();
    const bool last_chunk = (c & 15) == 15;
#pragma unroll
    for (int i = 0; i < 2; ++i) {
        const int idx = tid + i * NTHR, sp2 = idx & 63, dc = idx >> 6, s0 = sp2 * 2, d0 = dc * 8;
        const float ma = St[s0 * 2], ia = St[s0 * 2 + 1], mb = St[s0 * 2 + 2], ib = St[s0 * 2 + 3];
        const f32x4 g0 = lg0[i], g1 = lg1[i], b0 = lb0[i], b1 = lb1[i]; const u32x4 xa = ra[i], xb = rb[i];
        f32x4 a0, a1, c0, c1;
        a0[0] = (bf_lo(xa.x) - ma) * ia * g0[0] + b0[0]; a0[1] = (bf_hi(xa.x) - ma) * ia * g0[1] + b0[1]; a0[2] = (bf_lo(xa.y) - ma) * ia * g0[2] + b0[2]; a0[3] = (bf_hi(xa.y) - ma) * ia * g0[3] + b0[3];
        a1[0] = (bf_lo(xa.z) - ma) * ia * g1[0] + b1[0]; a1[1] = (bf_hi(xa.z) - ma) * ia * g1[1] + b1[1]; a1[2] = (bf_lo(xa.w) - ma) * ia * g1[2] + b1[2]; a1[3] = (bf_hi(xa.w) - ma) * ia * g1[3] + b1[3];
        c0[0] = (bf_lo(xb.x) - mb) * ib * g0[0] + b0[0]; c0[1] = (bf_hi(xb.x) - mb) * ib * g0[1] + b0[1]; c0[2] = (bf_lo(xb.y) - mb) * ib * g0[2] + b0[2]; c0[3] = (bf_hi(xb.y) - mb) * ib * g0[3] + b0[3];
        c1[0] = (bf_lo(xb.z) - mb) * ib * g1[0] + b1[0]; c1[1] = (bf_hi(xb.z) - mb) * ib * g1[1] + b1[1]; c1[2] = (bf_lo(xb.w) - mb) * ib * g1[2] + b1[2]; c1[3] = (bf_hi(xb.w) - mb) * ib * g1[3] + b1[3];
        if (last_chunk) {
            float* o = p.out + O_PCV + ((size_t)(c >> 4) * 128 + s0) * DM + C0 + d0;
            *(f32x4*)o = a0; *(f32x4*)(o + 4) = a1; *(f32x4*)(o + DM) = c0; *(f32x4*)(o + DM + 4) = c1;
        }
        LAS unsigned* vp = (LAS unsigned*)(Vt + d0 * SV + s0);
#pragma unroll
        for (int j = 0; j < 4; ++j) { vp[(j * SV) / 2] = cvt_pk_bf16(a0[j], c0[j]); vp[((4 + j) * SV) / 2] = cvt_pk_bf16(a1[j], c1[j]); }
    }
    __syncthreads();
    f32x4 acc[2][4];
#pragma unroll
    for (int i = 0; i < 2; ++i)
#pragma unroll
        for (int j = 0; j < 4; ++j) acc[i][j] = (f32x4){0.f, 0.f, 0.f, 0.f};
    for (int ks = 0; ks <= wt; ++ks) {
        bf16x8 af[2], bfr[4];
#pragma unroll
        for (int i = 0; i < 2; ++i) af[i] = *(const LAS bf16x8*)(Wt + (32 * wt + 16 * i + fr) * SW + 32 * ks + 8 * fq);
#pragma unroll
        for (int j = 0; j < 4; ++j) bfr[j] = *(const LAS bf16x8*)(Vt + (64 * wd + 16 * j + fr) * SV + 32 * ks + 8 * fq);
#pragma unroll
        for (int i = 0; i < 2; ++i)
#pragma unroll
            for (int j = 0; j < 4; ++j) acc[i][j] = __builtin_amdgcn_mfma_f32_16x16x32_bf16(bfr[j], af[i], acc[i][j], 0, 0, 0);
    }
#pragma unroll
    for (int i = 0; i < 2; ++i) {
        const int t = 32 * wt + 16 * i + fr;
        bf16_t* rowp = act + (size_t)(R0 + t) * DIN + C0 + 64 * wd + 4 * fq;
#pragma unroll
        for (int j = 0; j < 4; ++j) {
            const u32x2 u2 = uu[i][j], z2v = za[i][j];
            const f32x4 a = acc[i][j]; const float b = bs[i];
            const float z0 = bf_lo(z2v.x), z1 = bf_hi(z2v.x), z2 = bf_lo(z2v.y), z3 = bf_hi(z2v.y);
            u32x2 w; w.x = cvt_pk_bf16(gelu_t(bf_lo(u2.x)) * (a[0] + b) * (z0 * sigm(z0)), gelu_t(bf_hi(u2.x)) * (a[1] + b) * (z1 * sigm(z1)));
            w.y = cvt_pk_bf16(gelu_t(bf_lo(u2.y)) * (a[2] + b) * (z2 * sigm(z2)), gelu_t(bf_hi(u2.y)) * (a[3] + b) * (z3 * sigm(z3)));
            *(u32x2*)(rowp + C_U + 16 * j) = w;
        }
    }
    __syncthreads();
}

template <int W>
__device__ __forceinline__ void qpass_strip(const bf16_t* act, bf16_t* Q, int i0, int colg) {
    constexpr int NR = W + 7;
    const int pos0 = i0 & (SEQ - 1);
    const bf16_t* xcol = act + C_XB + colg;
    u32x4 xr[NR];
#pragma unroll
    for (int k = 0; k < NR; ++k) {
        const int d = k - (W - 1);
        if (pos0 + d >= 0) xr[k] = *(const u32x4*)(xcol + (size_t)(i0 + d) * DIN); else xr[k] = (u32x4){0u, 0u, 0u, 0u};
    }
    float S[8];
#pragma unroll
    for (int j = 0; j < 8; ++j) S[j] = 0.f;
#pragma unroll
    for (int k = 0; k < W - 1; ++k) { S[0] += bf_lo(xr[k].x); S[1] += bf_hi(xr[k].x); S[2] += bf_lo(xr[k].y); S[3] += bf_hi(xr[k].y); S[4] += bf_lo(xr[k].z); S[5] += bf_hi(xr[k].z); S[6] += bf_lo(xr[k].w); S[7] += bf_hi(xr[k].w); }
#pragma unroll
    for (int i = 0; i < 8; ++i) {
        const u32x4 x = xr[W - 1 + i], y = xr[i];
        const float xv[8] = {bf_lo(x.x), bf_hi(x.x), bf_lo(x.y), bf_hi(x.y), bf_lo(x.z), bf_hi(x.z), bf_lo(x.w), bf_hi(x.w)};
        const float yv[8] = {bf_lo(y.x), bf_hi(y.x), bf_lo(y.y), bf_hi(y.y), bf_lo(y.z), bf_hi(y.z), bf_lo(y.w), bf_hi(y.w)};
        const int pos = pos0 + i; const float ic = pos + 1 < W ? 1.0f / (float)(pos + 1) : 1.0f / (float)W;
        float qv[8];
#pragma unroll
        for (int j = 0; j < 8; ++j) { S[j] += xv[j]; qv[j] = S[j] * ic - xv[j]; S[j] -= yv[j]; }
        u32x4 o; o.x = cvt_pk_bf16(qv[0], qv[1]); o.y = cvt_pk_bf16(qv[2], qv[3]); o.z = cvt_pk_bf16(qv[4], qv[5]); o.w = cvt_pk_bf16(qv[6], qv[7]);
        *(u32x4*)(Q + (size_t)(i0 + i) * DM + colg) = o;
    }
}
__device__ __forceinline__ void phase_qpass(const Params& p) {
    const int tid = threadIdx.x, lane = tid & 63, wid = __builtin_amdgcn_readfirstlane(tid >> 6), G = gridDim.x, bid = blockIdx.x;
    const bf16_t* act = (const bf16_t*)(p.ws + WS_ACT);
    bf16_t* Q = (bf16_t*)((unsigned char*)p.out + DO_XN);
    const int g = wid & 3, strip = (wid >> 2) * 2 + (lane >> 5), colg = g * 256 + (lane & 31) * 8;
    for (int blk = bid; blk < MPR / 32; blk += G) {
        const int i0 = blk * 32 + strip * 8;
        if (g == 0) qpass_strip<2>(act, Q, i0, colg); else if (g == 1) qpass_strip<4>(act, Q, i0, colg); else if (g == 2) qpass_strip<8>(act, Q, i0, colg); else qpass_strip<16>(act, Q, i0, colg);
    }
    if (wid == 1) for (int it = bid * 64 + lane; it < MSM * 128; it += G * 64) {
        const int i = it >> 7, c8 = (it & 127) * 8, w = 2 << (c8 >> 8);
        const u32x4 x = *(const u32x4*)(act + (size_t)(MPR + i) * DIN + C_XB + c8);
        const float xv[8] = {bf_lo(x.x), bf_hi(x.x), bf_lo(x.y), bf_hi(x.y), bf_lo(x.z), bf_hi(x.z), bf_lo(x.w), bf_hi(x.w)};
        float S[8];
#pragma unroll
        for (int j = 0; j < 8; ++j) S[j] = xv[j];
        const float* sp = p.state_pool + (size_t)i * 15 * DM + c8;
#pragma unroll
        for (int j = 1; j < 16; ++j) {
            const f32x4 h0 = *(const f32x4*)(sp + (size_t)(15 - j) * DM), h1 = *(const f32x4*)(sp + (size_t)(15 - j) * DM + 4);
            const float mk = j < w ? 1.0f : 0.0f;
            S[0] += mk * h0[0]; S[1] += mk * h0[1]; S[2] += mk * h0[2]; S[3] += mk * h0[3]; S[4] += mk * h1[0]; S[5] += mk * h1[1]; S[6] += mk * h1[2]; S[7] += mk * h1[3];
        }
        const float invw = 1.0f / (float)w; float qv[8];
#pragma unroll
        for (int j = 0; j < 8; ++j) qv[j] = S[j] * invw - xv[j];
        u32x4 o; o.x = cvt_pk_bf16(qv[0], qv[1]); o.y = cvt_pk_bf16(qv[2], qv[3]); o.z = cvt_pk_bf16(qv[4], qv[5]); o.w = cvt_pk_bf16(qv[6], qv[7]);
        *(u32x4*)(Q + (size_t)(MPR + i) * DM + c8) = o;
    }
}

__device__ __forceinline__ void phase_mixpool(LAS unsigned char* lds, const Params& p) {
    const int tid = threadIdx.x, lane = tid & 63, wid = tid >> 6, G = gridDim.x, bid = blockIdx.x;
    phase_qpass(p);
    { int hprev = -1; for (int a = bid; a < 128 * 8; a += G) { const int h = a & 7; mix_unit(lds, p, a >> 3, h, h != hprev); hprev = h; } }
    bf16_t* act = (bf16_t*)(p.ws + WS_ACT);
    const float* statv = (const float*)(p.ws + WS_STATV);
    if (wid == 0) for (int r = bid; r < MSM; r += G) {
        const int row = MPR + r;
        float s, q;
        { const f32x2 v = *(const f32x2*)((const float*)(p.ws + WS_SVS) + ((size_t)r * 64 + lane) * 2); s = v.x; q = v.y; }
        s = wave_sum(s); q = wave_sum(q);
        const float mean = s * (1.0f / DM), rstd = 1.0f / sqrtf(fmaxf(q * (1.0f / DM) - mean * mean, 0.f) + EPS);
        bf16_t* rowp = act + (size_t)row * DIN;
#pragma unroll
        for (int i = 0; i < 4; ++i) {
            const int col = lane * 4 + 256 * i, h = col >> 7;
            const u32x2 gv = *(const u32x2*)(rowp + C_V + col), uu = *(const u32x2*)(rowp + C_U + col), za = *(const u32x2*)(rowp + C_ZA + col);
            const f32x4 lg = *(const f32x4*)(p.ln_g + col), lb = *(const f32x4*)(p.ln_b + col);
            const float w00 = p.w_s[(size_t)h * 128 * 128], bs = p.b_s[h * 128];
            f32x4 vn; vn[0] = (bf_lo(gv.x) - mean) * rstd * lg[0] + lb[0]; vn[1] = (bf_hi(gv.x) - mean) * rstd * lg[1] + lb[1];
            vn[2] = (bf_lo(gv.y) - mean) * rstd * lg[2] + lb[2]; vn[3] = (bf_hi(gv.y) - mean) * rstd * lg[3] + lb[3];
            *(f32x4*)(p.out + O_SCV + (size_t)r * DM + col) = vn;
            const float z0 = bf_lo(za.x), z1 = bf_hi(za.x), z2 = bf_lo(za.y), z3 = bf_hi(za.y);
            u32x2 o; o.x = cvt_pk_bf16(gelu_t(bf_lo(uu.x)) * (w00 * vn[0] + bs) * (z0 * sigm(z0)), gelu_t(bf_hi(uu.x)) * (w00 * vn[1] + bs) * (z1 * sigm(z1)));
            o.y = cvt_pk_bf16(gelu_t(bf_lo(uu.y)) * (w00 * vn[2] + bs) * (z2 * sigm(z2)), gelu_t(bf_hi(uu.y)) * (w00 * vn[3] + bs) * (z3 * sigm(z3)));
            *(u32x2*)(rowp + C_U + col) = o;
        }
    }
}

struct Row5 { f32x4 hv[4]; u32x2 tv[4]; f32x4 pv; float q; };
__device__ __forceinline__ void row5_load(const Params& p, int row, int lane, Row5& R) {
    const bf16_t* act = (const bf16_t*)(p.ws + WS_ACT);
    const float* hsrc = row < MPR ? p.x_prompt + (size_t)row * DM : p.x_sample + (size_t)(row - MPR) * DM;
    const float* psrc = row < MPR ? p.p_prompt + (size_t)row * PLE : p.p_sample + (size_t)(row - MPR) * PLE;
    R.q = row < MPR ? (lane < 16 ? ((const float*)(p.ws + WS_STATT))[(size_t)row * 16 + lane] : 0.f) : ((const float*)(p.ws + WS_STS))[(size_t)(row - MPR) * 64 + lane];
#pragma unroll
    for (int i = 0; i < 4; ++i) { const int col = lane * 4 + 256 * i; R.hv[i] = *(const f32x4*)(hsrc + col); R.tv[i] = *(const u32x2*)(act + (size_t)row * DIN + C_T + col); }
    R.pv = *(const f32x4*)(psrc + lane * 4);
}
__device__ __forceinline__ void row5_finish(const Params& p, int row, int lane, Row5& R) {
    bf16_t* arow = (bf16_t*)(p.ws + WS_ACT) + (size_t)row * DIN;
    const float rstd = 1.0f / sqrtf(wave_sum(R.q) * (1.0f / DM) + EPS);
    f32x4 h1[4]; float ss = 0.f;
#pragma unroll
    for (int i = 0; i < 4; ++i) {
        const int col = lane * 4 + 256 * i;
        const f32x4 gv = *(const f32x4*)(p.post_g + col);
        const f32x4 tv = (f32x4){bf_lo(R.tv[i].x), bf_hi(R.tv[i].x), bf_lo(R.tv[i].y), bf_hi(R.tv[i].y)};
        h1[i] = R.hv[i] + tv * rstd * gv;
        ss += (h1[i][0] * h1[i][0] + h1[i][1] * h1[i][1]) + (h1[i][2] * h1[i][2] + h1[i][3] * h1[i][3]);
        *(f32x4*)(p.out + (size_t)row * DM + col) = h1[i];
    }
    const float rstd1 = 1.0f / sqrtf(wave_sum(ss) * (1.0f / DM) + EPS);
#pragma unroll
    for (int i = 0; i < 4; ++i) {
        const int col = lane * 4 + 256 * i;
        const f32x4 gv = *(const f32x4*)(p.ple_in_g + col);
        u32x2 w; w.x = cvt_pk_bf16(h1[i][0] * rstd1 * gv[0], h1[i][1] * rstd1 * gv[1]); w.y = cvt_pk_bf16(h1[i][2] * rstd1 * gv[2], h1[i][3] * rstd1 * gv[3]);
        *(u32x2*)(arow + PLE + col) = w;
    }
    { u32x2 w; w.x = cvt_pk_bf16(R.pv[0], R.pv[1]); w.y = cvt_pk_bf16(R.pv[2], R.pv[3]); *(u32x2*)(arow + lane * 4) = w; }
}
__device__ __forceinline__ void phase_rows5(const Params& p, int first_row) {
    const int tid = threadIdx.x, lane = tid & 63, wid = tid >> 6, G = gridDim.x, bid = blockIdx.x, step = G * 8;
    int row = first_row + bid * 8 + wid;
    for (; row + step < MREAL; row += 2 * step) {
        Row5 a, b; row5_load(p, row, lane, a); row5_load(p, row + step, lane, b);
        row5_finish(p, row, lane, a); row5_finish(p, row + step, lane, b);
    }
    if (row < MREAL) { Row5 a; row5_load(p, row, lane, a); row5_finish(p, row, lane, a); }
}
struct Row7 { f32x4 hv[4]; u32x2 gv[4]; float q; };
__device__ __forceinline__ void row7_load(const Params& p, int row, int lane, Row7& R) {
    const bf16_t* act = (const bf16_t*)(p.ws + WS_ACT);
    R.q = row < MPR ? (lane < 16 ? ((const float*)(p.ws + WS_STATG))[(size_t)row * 16 + lane] : 0.f) : ((const float*)(p.ws + WS_SGS))[(size_t)(row - MPR) * 64 + lane];
#pragma unroll
    for (int i = 0; i < 4; ++i) { const int col = lane * 4 + 256 * i; R.hv[i] = *(const f32x4*)(p.out + (size_t)row * DM + col); R.gv[i] = *(const u32x2*)(act + (size_t)row * DIN + C_GE + col); }
}
__device__ __forceinline__ void row7_finish(const Params& p, int row, int lane, Row7& R) {
    const float rstd = 1.0f / sqrtf(wave_sum(R.q) * (1.0f / DM) + EPS);
#pragma unroll
    for (int i = 0; i < 4; ++i) {
        const int col = lane * 4 + 256 * i;
        const f32x4 g = *(const f32x4*)(p.ple_out_g + col);
        const f32x4 ge = (f32x4){bf_lo(R.gv[i].x), bf_hi(R.gv[i].x), bf_lo(R.gv[i].y), bf_hi(R.gv[i].y)};
        *(f32x4*)(p.out + (size_t)row * DM + col) = R.hv[i] + ge * rstd * g;
    }
}
__device__ __forceinline__ void phase_rows7(const Params& p, int first_row) {
    const int tid = threadIdx.x, lane = tid & 63, wid = tid >> 6, G = gridDim.x, bid = blockIdx.x, step = G * 8;
    int row = first_row + bid * 8 + wid;
    for (; row + step < MREAL; row += 2 * step) {
        Row7 a, b; row7_load(p, row, lane, a); row7_load(p, row + step, lane, b);
        row7_finish(p, row, lane, a); row7_finish(p, row + step, lane, b);
    }
    if (row < MREAL) { Row7 a; row7_load(p, row, lane, a); row7_finish(p, row, lane, a); }
}

__global__ void __launch_bounds__(NTHR, 2) fwd_megakernel(Params p) {
    extern __shared__ __attribute__((aligned(16))) unsigned char lds_raw[];
    LAS unsigned char* lds = (LAS unsigned char*)lds_raw;
    cg::grid_group grid = cg::this_grid();
    const int G = gridDim.x, bid = blockIdx.x;
    bf16_t* act = (bf16_t*)(p.ws + WS_ACT);
    volatile LAS unsigned* xb_st = (volatile LAS unsigned*)(lds + 131072);
    if (threadIdx.x < 4) xb_st[threadIdx.x] = 0u;
    __syncthreads();
    const XcdBarrier xbar = xcd_barrier_post((unsigned*)(p.ws + WS_BAR), xb_st);
#define SEAM() xcd_barrier(xbar)

    phase_prep(lds, p);
    SEAM();
    {
        pg8::Gemm g{(const bf16_t*)((unsigned char*)p.out + DO_XN), (const bf16_t*)((unsigned char*)p.out + DO_WIN), DM, DM, DM, 0};
        pg8::StaticOrder S; S.init(MPR / 256, DIN / 256, G, bid);
        EpiAct E{act, (float*)(p.ws + WS_STATV), p.out};
        pg8::gemm_phase<EpiAct, pg8::StaticOrder, K_ALIGN, K_SP2>(lds, g, S, E);
        small_gemm1<2>(p, g.A, g.lda, g.Bt, g.ldb, g.K, DIN / 32);
    }
    SEAM();
    phase_mixpool(lds, p);
    SEAM();
    {
        pg8::Gemm g{(const bf16_t*)((unsigned char*)p.out + DO_XN), (const bf16_t*)(p.ws + WS_WPOOL), DM, 256, 256, 256 * 2};
        pg8::StaticOrder S; S.init(MPR / 256, 4, G, bid);
        EpiPool E{act, p.pool_scale};
        pg8::gemm_phase<EpiPool, pg8::StaticOrder, K_ALIGN, K_SP2, PreSmall2<2>>(lds, g, S, E, PreSmall2<2>{lds, p, g.A, g.lda, g.Bt, g.ldb});
    }
    SEAM();
    {
        pg8::Gemm g{act + C_U, (const bf16_t*)(p.ws + WS_WCAT), DIN, 2048, 2048, 0};
        pg8::StaticOrder S; S.init(MPR / 256, 4, G, bid);
        EpiMerge E{act};
        pg8::gemm_phase<EpiMerge, pg8::StaticOrder, K_ALIGN, K_SP2, PreSmall2<3>>(lds, g, S, E, PreSmall2<3>{lds, p, g.A, g.lda, g.Bt, g.ldb});
    }
    SEAM();
    const bool fusedn = (G == 256);
    {
        pg8::Gemm g{act + C_M, (const bf16_t*)(p.ws + WS_WOUT), DIN, 1024, 1024, 0};
        pg8::StaticOrder S; S.init(MPR / 256, 4, G, bid);
        if (fusedn) {
            for (int row = bid * 8 + (threadIdx.x >> 6); row < MPR; row += G * 8) {
                const int lane = threadIdx.x & 63; const f32x4 pv = *(const f32x4*)(p.p_prompt + (size_t)row * PLE + lane * 4);
                u32x2 w; w.x = cvt_pk_bf16(pv[0], pv[1]); w.y = cvt_pk_bf16(pv[2], pv[3]); *(u32x2*)(act + (size_t)row * DIN + lane * 4) = w;
            }
            float* xb = (float*)(p.ws + WS_XBUF); unsigned* xc = (unsigned*)(p.ws + WS_XCNT);
            EpiOutF E{act, p.x_prompt, (float*)(p.ws + WS_RSTD1), p.post_g, p.ple_in_g, RowX{xb, xc}, RowX{xb + 64 * 256 * 4, xc + 64 * 64}};
            pg8::gemm_phase<EpiOutF, pg8::StaticOrder, false, K_SP2, PreSmall2<4>>(lds, g, S, E, PreSmall2<4>{lds, p, g.A, g.lda, g.Bt, g.ldb});
        } else {
            EpiOut E{act, (float*)(p.ws + WS_STATT)};
            pg8::gemm_phase<EpiOut, pg8::StaticOrder, K_ALIGN, K_SP2, PreSmall2<4>>(lds, g, S, E, PreSmall2<4>{lds, p, g.A, g.lda, g.Bt, g.ldb});
        }
    }
    SEAM();
    phase_rows5(p, fusedn ? MPR : 0);
    SEAM();
    {
        pg8::Gemm g{act, (const bf16_t*)(p.ws + WS_W6), DIN, 1280, 1280, 0};
        pg8::StaticOrder S; S.init(MPR / 256, 4, G, bid);
        if (fusedn) {
            EpiGateF E{act, p.out, p.ple_out_g, p.ple_in_g, (const float*)(p.ws + WS_RSTD1), RowX{(float*)(p.ws + WS_XBUF) + 2 * 64 * 256 * 4, (unsigned*)(p.ws + WS_XCNT) + 2 * 64 * 64}};
            pg8::gemm_phase<EpiGateF, pg8::StaticOrder, false, K_SP2, PreSmall2<6>>(lds, g, S, E, PreSmall2<6>{lds, p, g.A, g.lda, g.Bt, g.ldb});
        } else {
            EpiGate E{act, (float*)(p.ws + WS_STATG)};
            pg8::gemm_phase<EpiGate, pg8::StaticOrder, K_ALIGN, K_SP2, PreSmall2<6>>(lds, g, S, E, PreSmall2<6>{lds, p, g.A, g.lda, g.Bt, g.ldb});
        }
    }
    SEAM();
    phase_rows7(p, fusedn ? MPR : 0);
    if (gridDim.y > 1) grid.sync();
}

extern "C" void kernel_launch(void* const* d_in, const int* in_sizes, int n_in, void* d_out, int out_size, void* d_ws, size_t ws_size, hipStream_t stream) {
    constexpr size_t kDynLds = LDS_BYTES;
    static int grid_blocks = 0;
    if (!grid_blocks) {
        if (ws_size < WS_END) { fprintf(stderr, "kernel_launch: workspace too small: %zu < %zu\n", ws_size, (size_t)WS_END); grid_blocks = -1; return; }
        int dev = 0, cus = 0, per_cu = 0;
        (void)hipGetDevice(&dev);
        (void)hipDeviceGetAttribute(&cus, hipDeviceAttributeMultiprocessorCount, dev);
        (void)hipFuncSetAttribute((const void*)fwd_megakernel, hipFuncAttributeMaxDynamicSharedMemorySize, (int)kDynLds);
        (void)hipOccupancyMaxActiveBlocksPerMultiprocessor(&per_cu, (const void*)fwd_megakernel, NTHR, kDynLds);
        if (per_cu < 1) { fprintf(stderr, "kernel_launch: occupancy query says %d blocks per CU\n", per_cu); per_cu = 1; }
        grid_blocks = cus;
    }
    if (grid_blocks < 0) return;
    if (hipMemsetAsync((unsigned char*)d_ws + WS_BAR, 0, ZERO_BYTES, stream) != hipSuccess) { fprintf(stderr, "kernel_launch: memset of the barrier words failed\n"); return; }
    Params p{};
    const float** f = (const float**)&p;
    for (int i = 0; i < 21; ++i) f[i] = (const float*)d_in[i];
    p.out = (float*)d_out; p.ws = (unsigned char*)d_ws;
    void* args[] = {&p};
    hipError_t e = hipLaunchCooperativeKernel((const void*)fwd_megakernel, dim3(grid_blocks), dim3(NTHR), args, kDynLds, stream);
    if (e != hipSuccess) fprintf(stderr, "cooperative launch failed: %s (grid %d)\n", hipGetErrorString(e), grid_blocks);
}
```

```cpp
#ifndef K_SP2
#define K_SP2 true
#endif
#ifndef K_ALIGN
#define K_ALIGN true
#endif
#include <hip/hip_runtime.h>
#include <hip/hip_cooperative_groups.h>
#include <cstdio>
namespace cg = cooperative_groups;

#define LAS __attribute__((address_space(3)))
typedef unsigned short bf16_t;
typedef short bf16x8 __attribute__((ext_vector_type(8)));
typedef float f32x4 __attribute__((ext_vector_type(4)));
typedef float f32x2 __attribute__((ext_vector_type(2)));
typedef unsigned u32x4 __attribute__((ext_vector_type(4)));
typedef unsigned u32x2 __attribute__((ext_vector_type(2)));

constexpr int DM = 1024, MPR = 16384, MSM = 128, MREAL = MPR + MSM, MT = 16640, DIN = 7168, PLE = 256, SEQ = 2048;
constexpr int NTHR = 512;
constexpr int XCD_BAR_WORDS_C = 3456;
constexpr int LDS_BYTES = 131072 + 64 + 8192;
constexpr float EPS = 1e-6f;
constexpr int C_U = 0, C_ZB = 1024, C_V = 2048, C_ZA = 3072, C_XB = 4096, C_GA = 5120, C_GB = 6144;
constexpr int C_M = 2048;
constexpr int C_E = 2048;
constexpr int C_T = 3072;
constexpr int C_GE = 5120;
constexpr int LDF = DIN / 2;
constexpr int CF_T = 1536;
constexpr int CF_GE = 2560;
constexpr size_t O_YP = 0, O_YS = (size_t)MPR * DM, O_PCV = O_YS + (size_t)MSM * DM, O_PP = O_PCV + (size_t)8 * 128 * DM,
                 O_SCV = O_PP + (size_t)8 * 15 * DM, O_SP = O_SCV + (size_t)MSM * DM;
constexpr size_t DO_XN = 0, DO_WIN = (size_t)MT * DM * 2;
constexpr size_t WS_ACT = 0;
constexpr size_t WS_WCAT = WS_ACT + (size_t)MT * DIN * 2;
constexpr size_t WS_WOUT = WS_WCAT + (size_t)1024 * 2048 * 2;
constexpr size_t WS_W6 = WS_WOUT + (size_t)1024 * 1024 * 2;
constexpr size_t WS_WPOOL = WS_W6 + (size_t)1024 * 1280 * 2;
constexpr size_t WS_WS = WS_WPOOL + (size_t)4 * 256 * 256 * 2;
constexpr size_t WS_STATV = WS_WS + (size_t)8 * 128 * 128 * 2;
constexpr size_t WS_STATT = WS_STATV + (size_t)MT * 16 * 2 * 4;
constexpr size_t WS_STATG = WS_STATT + (size_t)MT * 16 * 4;
constexpr size_t WS_BAR = WS_STATG + (size_t)MT * 16 * 4;
constexpr size_t WS_XCNT = WS_BAR + (size_t)XCD_BAR_WORDS_C * 4;
constexpr size_t WS_XBUF = WS_XCNT + (size_t)3 * 64 * 64 * 4;
constexpr size_t ZERO_BYTES = WS_XBUF - WS_BAR;
constexpr size_t WS_SVS = WS_XBUF + (size_t)3 * 64 * 256 * 4 * 4;
constexpr size_t WS_STS = WS_SVS + (size_t)MSM * 64 * 2 * 4;
constexpr size_t WS_SGS = WS_STS + (size_t)MSM * 64 * 4;
constexpr size_t WS_RSTD1 = WS_SGS + (size_t)MSM * 64 * 4;
constexpr size_t WS_END = WS_RSTD1 + (size_t)MPR * 4;

struct Params {
    const float* x_prompt; const float* x_sample; const float* state_pool; const float* p_prompt; const float* p_sample;
    const float* pre_g; const float* w_in; const float* ln_g; const float* ln_b; const float* w_s; const float* b_s;
    const float* w_pool; const float* pool_scale; const float* w_pa; const float* w_pb; const float* w_out; const float* post_g;
    const float* w_ple; const float* w_pg; const float* ple_in_g; const float* ple_out_g;
    float* out; unsigned char* ws;
};

typedef __bf16 bf16x2_t __attribute__((ext_vector_type(2)));
__device__ __forceinline__ unsigned cvt_pk_bf16(float lo, float hi) { const bf16x2_t r = __builtin_convertvector((f32x2){lo, hi}, bf16x2_t); return __builtin_bit_cast(unsigned, r); }
__device__ __forceinline__ float bf_lo(unsigned w) { return __uint_as_float(w << 16); }
__device__ __forceinline__ float bf_hi(unsigned w) { return __uint_as_float(w & 0xffff0000u); }
__device__ __forceinline__ float sigm(float x) { return __builtin_amdgcn_rcpf(1.0f + __builtin_amdgcn_exp2f(-1.44269504089f * x)); }
__device__ __forceinline__ float gelu_t(float x) { return x * __builtin_amdgcn_rcpf(1.0f + __builtin_amdgcn_exp2f(x * (-2.30220819f - 0.10294324f * x * x))); }
__device__ __forceinline__ float wave_sum(float v) {
#pragma unroll
    for (int o = 32; o >= 1; o >>= 1) v += __shfl_xor(v, o);
    return v;
}


#define XB_TMO      128
#define XB_XCNT(j)  (256  + 64 * (j))
#define XB_XSUB(j)  (1280 + 64 * (j))
#define XB_XGEN(j)  (2304 + 64 * (j))
#define XB_TOP      3328
#define XB_TOPGEN   3392
#define XCD_BAR_WORDS 3456
#define XB_SPIN_CAP (1u << 18)
__device__ __forceinline__ unsigned xb_ld(unsigned* p)              { return __hip_atomic_load(p, __ATOMIC_RELAXED, __HIP_MEMORY_SCOPE_AGENT); }
__device__ __forceinline__ unsigned xb_add(unsigned* p, unsigned v) { return __hip_atomic_fetch_add(p, v, __ATOMIC_RELAXED, __HIP_MEMORY_SCOPE_AGENT); }
__device__ __forceinline__ unsigned xb_xcc_id() { return (unsigned)__builtin_amdgcn_s_getreg((3 << 11) | 20) & 0xFu; }
#define XB_SPIN(cond, bar) do { unsigned _sp = 0; while (cond) { __builtin_amdgcn_s_sleep(1); \
    if ((++_sp & 255u) == 0u) { if (xb_ld(&(bar)[XB_TMO])) break; if (_sp > XB_SPIN_CAP) { atomicAdd(&(bar)[XB_TMO], 1u); break; } } } } while (0)
struct XcdBarrier { unsigned* bar; unsigned x; volatile LAS unsigned* st; };
__device__ __forceinline__ XcdBarrier xcd_barrier_post(unsigned* bar, volatile LAS unsigned* st) {
    XcdBarrier b; b.bar = bar; b.x = xb_xcc_id(); b.st = st;
    if (threadIdx.x == 0) (void)xb_add(&bar[XB_XCNT(b.x)], 1u);
    return b;
}
__device__ __forceinline__ void xcd_barrier_complete(unsigned* bar, unsigned x, unsigned& nloc, unsigned& nx) {
    const unsigned G = gridDim.x * gridDim.y * gridDim.z;
    unsigned sum, cnt, mine, sp = 0u;
    for (;;) {
        sum = 0u; cnt = 0u; mine = 0u;
#pragma unroll
        for (unsigned j = 0; j < 16; ++j) { const unsigned c = xb_ld(&bar[XB_XCNT(j)]); sum += c; cnt += (c > 0u) ? 1u : 0u; mine = (j == x) ? c : mine; }
        if (sum == G) break;
        __builtin_amdgcn_s_sleep(1);
        if ((++sp & 255u) == 0u) { if (xb_ld(&bar[XB_TMO])) break; if (sp > XB_SPIN_CAP) { atomicAdd(&bar[XB_TMO], 1u); break; } }
    }
    nloc = mine > 0u ? mine : 1u; nx = cnt > 0u ? cnt : 1u;
}
__device__ __forceinline__ void xcd_barrier(const XcdBarrier& b) {
    asm volatile("s_waitcnt vmcnt(0)" ::: "memory");
    __syncthreads();
    if (threadIdx.x == 0) {
        unsigned* bar = b.bar;
        __builtin_amdgcn_s_waitcnt(0);
        unsigned nloc = b.st[0], nx = b.st[1];
        if (nloc == 0u) { xcd_barrier_complete(bar, b.x, nloc, nx); b.st[0] = nloc; b.st[1] = nx; }
        const unsigned old = xb_add(&bar[XB_XSUB(b.x)], 1u);
        const unsigned gen = old / nloc;
        if (old + 1u == (gen + 1u) * nloc) {
            __builtin_amdgcn_fence(__ATOMIC_RELEASE, "agent");
            asm volatile("s_waitcnt vmcnt(0)" ::: "memory");
            const unsigned og = xb_add(&bar[XB_TOP], 1u);
            const unsigned tg = og / nx;
            if (og + 1u == (tg + 1u) * nx) xb_add(&bar[XB_TOPGEN], 1u);
            else XB_SPIN(xb_ld(&bar[XB_TOPGEN]) == tg, bar);
            __builtin_amdgcn_fence(__ATOMIC_ACQUIRE, "agent");
            xb_add(&bar[XB_XGEN(b.x)], 1u);
            asm volatile("s_waitcnt vmcnt(0)" ::: "memory");
        } else {
            XB_SPIN(xb_ld(&bar[XB_XGEN(b.x)]) == gen, bar);
            __builtin_amdgcn_fence(__ATOMIC_ACQUIRE, "agent");
            asm volatile("s_waitcnt vmcnt(0)" ::: "memory");
        }
    }
    __syncthreads();
}

namespace pg8 {
constexpr int BM = 256, BK = 64, HALF = 128, HTB = HALF * BK * 2, STAGE_BYTES = 8 * HTB, NXCD = 8, WGM = 8;
__host__ __device__ __forceinline__ int lds_byte(int r, int c) { const int st = (r >> 4) * 2 + (c >> 5), rr = r & 15, cc = c & 31, ob = rr * 64 + cc * 2; return st * 1024 + (ob ^ (((ob >> 9) & 1) << 5)); }
__host__ __device__ __forceinline__ void stage_rc(int b, int& R, int& C) { const int st = b / 1024, sb = b % 1024, swz = sb ^ (((sb >> 9) & 1) << 5); R = (st >> 1) * 16 + swz / 64; C = (st & 1) * 32 + (swz % 64) / 2; }
__host__ __device__ __forceinline__ int perm32(int rho) { const int n = rho >> 4, i = rho & 15; return 8 * (i >> 2) + 4 * n + (i & 3); }

struct Unit { int pm, pn; };
struct Gemm { const bf16_t* A; const bf16_t* Bt; int lda, ldb, K, a_pn_off; };

struct StaticOrder {
    int nM, nN, nwg, G, c;
    __device__ void init(int nM_, int nN_, int G_, int c_) { nM = nM_; nN = nN_; nwg = nM * nN; G = G_; c = c_; }
    __device__ bool next(int i, Unit& u) const {
        const long L = (long)i * G + c; if (L >= nwg) return false;
        int wgid = (int)L; { const int q = nwg / NXCD, r = nwg % NXCD, xcd = wgid % NXCD, off = wgid / NXCD; wgid = (xcd < r ? xcd * (q + 1) : r * (q + 1) + (xcd - r) * q) + off; }
        const int nig = WGM * nN, gid = wgid / nig, fm = gid * WGM, gsz = (nM - fm) < WGM ? (nM - fm) : WGM;
        u.pm = fm + ((wgid % nig) % gsz); u.pn = (wgid % nig) / gsz; return true;
    }
};

struct NoPre { __device__ __forceinline__ void operator()() const {} };
template <class Epi, class Sched, bool ALIGN_EPI = false, bool SP2 = false, class Pre = NoPre>
__device__ __forceinline__ void gemm_phase(LAS unsigned char* lds, const Gemm g, const Sched& S, const Epi& E, const Pre& pre = Pre()) {
    const int tid = threadIdx.x, wid = __builtin_amdgcn_readfirstlane(tid >> 6), lane = tid & 63, wr = wid >> 2, wc = wid & 3, fr = lane & 15, fq = lane >> 4;
    const int K = g.K, nt = K / BK;
    unsigned voffA[2], voffB[2];
#pragma unroll
    for (int i = 0; i < 2; ++i) { int R, C; stage_rc(tid * 16 + i * 8192, R, C); const int Rb = Epi::PERM ? ((R & ~31) + perm32(R & 31)) : R;
        voffA[i] = (unsigned)(R * g.lda + C) * 2u; voffB[i] = (unsigned)(Rb * g.ldb + C) * 2u; }
    const size_t kstep = (size_t)(BK * 2);
    const size_t hstepA = (size_t)HALF * g.lda * 2, hstepB = (size_t)HALF * g.ldb * 2;
    const size_t tstepA = 2 * hstepA, tstepB = 2 * hstepB;
    const unsigned ldsw = (unsigned)wid * 1024u;
    const int aoff = lds_byte(wr * 64 + fr, fq * 8), boff = lds_byte(wc * 32 + fr, fq * 8);
#define PG8_SA(b, h) (((b) * 2 + (h)) * HTB)
#define PG8_SB(b, h) ((4 + (b) * 2 + (h)) * HTB)
#define PG8_STAGE(bufoff, gbase, voff) do { _Pragma("unroll") for (int _i = 0; _i < 2; ++_i) \
        __builtin_amdgcn_global_load_lds((const unsigned*)((const char*)(gbase) + (voff)[_i]), (LAS unsigned*)(lds + (bufoff) + ldsw + _i * 8192), 16, 0, 0); } while (0)
#define PG8_LDA(dst, b, h) do { _Pragma("unroll") for (int m = 0; m < 4; ++m) _Pragma("unroll") for (int k = 0; k < 2; ++k) dst[m][k] = *(const LAS bf16x8*)(lds + PG8_SA(b, h) + aoff + m * 2048 + k * 1024); } while (0)
#define PG8_LDB(dst, b, h) do { _Pragma("unroll") for (int n = 0; n < 2; ++n) _Pragma("unroll") for (int k = 0; k < 2; ++k) dst[n][k] = *(const LAS bf16x8*)(lds + PG8_SB(b, h) + boff + n * 2048 + k * 1024); } while (0)
#define PG8_MMA(ai, bj, At, Bt) do { __builtin_amdgcn_s_setprio(1); _Pragma("unroll") for (int m = 0; m < 4; ++m) _Pragma("unroll") for (int n = 0; n < 2; ++n) _Pragma("unroll") for (int k = 0; k < 2; ++k) \
        acc[ai][bj][m][n] = __builtin_amdgcn_mfma_f32_16x16x32_bf16(Bt[n][k], At[m][k], acc[ai][bj][m][n], 0, 0, 0); __builtin_amdgcn_s_setprio(0); } while (0)
#define PG8_WAIT_V(n) asm volatile("s_waitcnt vmcnt(" #n ")" ::: "memory")
#define PG8_WAIT_L(n) asm volatile("s_waitcnt lgkmcnt(" #n ")" ::: "memory")
#define PG8_BAR __builtin_amdgcn_s_barrier()
#define PG8_SCHED __builtin_amdgcn_sched_barrier(0)
    Unit cur, nxt; int ui = 0;
    if (!S.next(0, cur)) { pre(); return; }
    f32x4 acc[2][2][4][2];
#pragma unroll
    for (int a = 0; a < 2; ++a)
#pragma unroll
        for (int b = 0; b < 2; ++b)
#pragma unroll
            for (int m = 0; m < 4; ++m)
#pragma unroll
                for (int n = 0; n < 2; ++n) acc[a][b][m][n] = (f32x4){0.f, 0.f, 0.f, 0.f};
    bf16x8 At[4][2], B0[2][2], B1[2][2];
    const char* cA = (const char*)g.A + (size_t)cur.pm * tstepA + (size_t)cur.pn * g.a_pn_off; const char* cB = (const char*)g.Bt + (size_t)cur.pn * tstepB;
    if constexpr (SP2) {
        PG8_STAGE(PG8_SB(0, 0), cB, voffB); PG8_STAGE(PG8_SB(0, 1), cB + hstepB, voffB); PG8_STAGE(PG8_SA(0, 0), cA, voffA); PG8_STAGE(PG8_SA(0, 1), cA + hstepA, voffA);
        pre();
        if (wr == 1) PG8_BAR;
        PG8_WAIT_V(2); PG8_BAR;
        PG8_STAGE(PG8_SB(1, 0), cB + kstep, voffB); PG8_STAGE(PG8_SA(1, 0), cA + kstep, voffA); PG8_STAGE(PG8_SB(1, 1), cB + hstepB + kstep, voffB);
        PG8_WAIT_V(6); PG8_BAR;
    } else {
        PG8_STAGE(PG8_SB(0, 0), cB, voffB); PG8_STAGE(PG8_SA(0, 0), cA, voffA); PG8_STAGE(PG8_SB(0, 1), cB + hstepB, voffB); PG8_STAGE(PG8_SA(0, 1), cA + hstepA, voffA);
        pre();
        if (wr == 1) PG8_BAR;
        PG8_WAIT_V(4); PG8_BAR;
        PG8_STAGE(PG8_SB(1, 0), cB + kstep, voffB); PG8_STAGE(PG8_SA(1, 0), cA + kstep, voffA); PG8_STAGE(PG8_SB(1, 1), cB + hstepB + kstep, voffB);
        PG8_WAIT_V(6); PG8_BAR;
    }
    for (;;) {
        const bool has_next = S.next(ui + 1, nxt);
        const char* nA = has_next ? (const char*)g.A + (size_t)nxt.pm * tstepA + (size_t)nxt.pn * g.a_pn_off : cA; const char* nB = has_next ? (const char*)g.Bt + (size_t)nxt.pn * tstepB : cB;
        int t = 0;
#pragma unroll 1
        for (int seg = 0; seg < (Epi::MID_T >= 0 ? 2 : 1); ++seg) {
        const int tend = (Epi::MID_T >= 0 && seg == 0) ? Epi::MID_T : nt;
#pragma unroll 1
        for (; t < tend; t += 2) {
            const bool last = (t == nt - 2);
            const char* a1 = cA + (size_t)(t + 1) * kstep;
            const char* a2 = last ? nA : cA + (size_t)(t + 2) * kstep; const char* b2 = last ? nB : cB + (size_t)(t + 2) * kstep;
            const char* a3 = a2 + kstep; const char* b3 = b2 + kstep;
            if constexpr (SP2) {
            PG8_LDB(B0, 0, 0); PG8_LDB(B1, 0, 1); PG8_SCHED; PG8_LDA(At, 0, 0); PG8_STAGE(PG8_SA(1, 1), a1 + hstepA, voffA);
            PG8_WAIT_V(8); PG8_WAIT_L(0); PG8_BAR; PG8_MMA(0, 0, At, B0); PG8_MMA(0, 1, At, B1); PG8_BAR; PG8_SCHED;
            PG8_LDA(At, 0, 1); PG8_STAGE(PG8_SB(0, 0), b2, voffB); PG8_STAGE(PG8_SB(0, 1), b2 + hstepB, voffB); PG8_STAGE(PG8_SA(0, 0), a2, voffA);
            PG8_WAIT_V(8); PG8_WAIT_L(0); PG8_BAR; PG8_MMA(1, 0, At, B0); PG8_MMA(1, 1, At, B1); PG8_BAR; PG8_SCHED;
            PG8_LDB(B0, 1, 0); PG8_LDB(B1, 1, 1); PG8_SCHED; PG8_LDA(At, 1, 0); PG8_STAGE(PG8_SA(0, 1), a2 + hstepA, voffA);
            PG8_WAIT_V(8); PG8_WAIT_L(0); PG8_BAR; PG8_MMA(0, 0, At, B0); PG8_MMA(0, 1, At, B1); PG8_BAR; PG8_SCHED;
            PG8_LDA(At, 1, 1); PG8_STAGE(PG8_SB(1, 0), b3, voffB); PG8_STAGE(PG8_SB(1, 1), b3 + hstepB, voffB); PG8_STAGE(PG8_SA(1, 0), a3, voffA);
            PG8_WAIT_V(8); PG8_WAIT_L(0); PG8_BAR; PG8_MMA(1, 0, At, B0); PG8_MMA(1, 1, At, B1); PG8_BAR; PG8_SCHED;
            } else {
            PG8_LDB(B0, 0, 0); PG8_SCHED; PG8_LDA(At, 0, 0); PG8_STAGE(PG8_SA(1, 1), a1 + hstepA, voffA);
            PG8_WAIT_L(8); PG8_BAR; PG8_WAIT_L(0); PG8_MMA(0, 0, At, B0); PG8_BAR; PG8_SCHED;
            PG8_LDB(B1, 0, 1); PG8_STAGE(PG8_SB(0, 0), b2, voffB);
            PG8_BAR; PG8_WAIT_L(0); PG8_MMA(0, 1, At, B1); PG8_BAR;
            PG8_LDA(At, 0, 1); PG8_STAGE(PG8_SA(0, 0), a2, voffA);
            PG8_BAR; PG8_WAIT_L(0); PG8_MMA(1, 0, At, B0); PG8_BAR; PG8_SCHED;
            PG8_STAGE(PG8_SB(0, 1), b2 + hstepB, voffB);
            PG8_WAIT_V(6); PG8_BAR; PG8_MMA(1, 1, At, B1); PG8_BAR;
            PG8_LDB(B0, 1, 0); PG8_SCHED; PG8_LDA(At, 1, 0); PG8_STAGE(PG8_SA(0, 1), a2 + hstepA, voffA);
            PG8_WAIT_L(8); PG8_BAR; PG8_WAIT_L(0); PG8_MMA(0, 0, At, B0); PG8_BAR; PG8_SCHED;
            PG8_LDB(B1, 1, 1); PG8_STAGE(PG8_SB(1, 0), b3, voffB);
            PG8_BAR; PG8_WAIT_L(0); PG8_MMA(0, 1, At, B1); PG8_BAR;
            PG8_LDA(At, 1, 1); PG8_STAGE(PG8_SA(1, 0), a3, voffA);
            PG8_BAR; PG8_WAIT_L(0); PG8_MMA(1, 0, At, B0); PG8_BAR; PG8_SCHED;
            PG8_STAGE(PG8_SB(1, 1), b3 + hstepB, voffB);
            PG8_WAIT_V(6); PG8_BAR; PG8_MMA(1, 1, At, B1); PG8_BAR;
            }
        }
        if (Epi::MID_T >= 0 && seg == 0) {
            if (wr == 0) PG8_BAR;
            E.mid(acc, cur, wr, wc, fr, fq);
            if (wr == 1) PG8_BAR;
        }
        }
        if constexpr (ALIGN_EPI) { if (wr == 0) PG8_BAR; }
        if constexpr (!Epi::AFTER_DRAIN) E(acc, cur, wr, wc, fr, fq);
        if (!has_next) break;
#pragma unroll
        for (int a = 0; a < 2; ++a)
#pragma unroll
            for (int b = 0; b < 2; ++b)
#pragma unroll
                for (int m = 0; m < 4; ++m)
#pragma unroll
                    for (int n = 0; n < 2; ++n) acc[a][b][m][n] = (f32x4){0.f, 0.f, 0.f, 0.f};
        cur = nxt; cA = nA; cB = nB; ++ui;
        if constexpr (ALIGN_EPI) { if (wr == 1) PG8_BAR; }
    }
    PG8_WAIT_V(0);
    if constexpr (!ALIGN_EPI) { if (wr == 0) PG8_BAR; }
    PG8_BAR;
    if constexpr (Epi::AFTER_DRAIN) E.fused(acc, cur, wr, wc, fr, fq, lds, wid, lane);
#undef PG8_SA
#undef PG8_SB
#undef PG8_STAGE
#undef PG8_LDA
#undef PG8_LDB
#undef PG8_MMA
#undef PG8_WAIT_V
#undef PG8_WAIT_L
#undef PG8_BAR
#undef PG8_SCHED
}
}
using pg8::Unit;
typedef f32x4 Acc[2][2][4][2];

struct EpiAct {
    static constexpr bool PERM = true, AFTER_DRAIN = false; static constexpr int MID_T = -1;
    bf16_t* act; float* statv; float* out;
    __device__ __forceinline__ void mid(Acc&, const Unit&, int, int, int, int) const {}
    template <int KIND> __device__ __forceinline__ void run(Acc& acc, const Unit& u, int wr, int wc, int fr, int fq) const {
        const int blk = u.pn >> 2;
        int row0 = u.pm * 256 + wr * 64 + fr, col0 = u.pn * 256 + wc * 32 + 8 * fq; asm volatile("" : "+v"(row0), "+v"(col0));
#pragma unroll
        for (int ai = 0; ai < 2; ++ai)
#pragma unroll
            for (int m = 0; m < 4; ++m) {
                const int row = row0 + ai * 128 + m * 16;
                bf16_t* rowp = act + (size_t)row * DIN + col0;
                float s = 0.f, q = 0.f;
#pragma unroll
                for (int bj = 0; bj < 2; ++bj) {
                    f32x4 v0 = acc[ai][bj][m][0], v1 = acc[ai][bj][m][1];
#pragma unroll
                    for (int j = 0; j < 4; ++j) {
                        if (KIND == 0) { v0[j] = gelu_t(v0[j]); v1[j] = gelu_t(v1[j]); }
                        if (KIND == 1) { v0[j] = v0[j] * sigm(v0[j]); v1[j] = v1[j] * sigm(v1[j]); }
                        if (KIND == 3) { v0[j] = sigm(v0[j]); v1[j] = sigm(v1[j]); }
                    }
                    if (KIND == 0) {
#pragma unroll
                        for (int j = 0; j < 4; ++j) { s += v0[j] + v1[j]; q += v0[j] * v0[j] + v1[j] * v1[j]; }
                    }
                    u32x4 w; w.x = cvt_pk_bf16(v0[0], v0[1]); w.y = cvt_pk_bf16(v0[2], v0[3]); w.z = cvt_pk_bf16(v1[0], v1[1]); w.w = cvt_pk_bf16(v1[2], v1[3]);
                    *(u32x4*)(rowp + bj * 128) = w;
                    if (KIND == 2 && blk == 4) {
                        const int cb = (u.pn & 3) * 256 + wc * 32 + 8 * fq + bj * 128;
                        float* dst = nullptr;
                        if (row < MPR) { const int pos = row & (SEQ - 1); if (pos >= SEQ - 15) dst = out + O_PP + ((size_t)(row >> 11) * 15 + (pos - (SEQ - 15))) * DM + cb; }
                        else if (row < MREAL) dst = out + O_SP + ((size_t)(row - MPR) * 15 + 14) * DM + cb;
                        if (dst) { *(f32x4*)dst = v0; *(f32x4*)(dst + 4) = v1; }
                    }
                }
                if (KIND == 0 && blk == 2) {
                    s += __shfl_xor(s, 16); s += __shfl_xor(s, 32); q += __shfl_xor(q, 16); q += __shfl_xor(q, 32);
                    if (fq == 0) *(f32x2*)(statv + ((size_t)row * 16 + (u.pn & 3) * 4 + wc) * 2) = (f32x2){s, q};
                }
            }
    }
    __device__ __forceinline__ void operator()(Acc& acc, const Unit& u, int wr, int wc, int fr, int fq) const {
        const int blk = u.pn >> 2;
        if (blk == 2) run<0>(acc, u, wr, wc, fr, fq);
        else if (blk == 1) run<1>(acc, u, wr, wc, fr, fq);
        else if (blk == 0 || blk == 3 || blk == 4) run<2>(acc, u, wr, wc, fr, fq);
        else run<3>(acc, u, wr, wc, fr, fq);
    }
};


struct EpiPool {
    static constexpr bool PERM = true, AFTER_DRAIN = false; static constexpr int MID_T = -1;
    bf16_t* act; const float* scale;
    __device__ __forceinline__ void mid(Acc&, const Unit&, int, int, int, int) const {}
    __device__ __forceinline__ void operator()(Acc& acc, const Unit& u, int wr, int wc, int fr, int fq) const {
        int row0 = u.pm * 256 + wr * 64 + fr, col0 = u.pn * 256 + wc * 32 + 8 * fq; asm volatile("" : "+v"(row0), "+v"(col0));
        f32x4 sc[2][2];
#pragma unroll
        for (int bj = 0; bj < 2; ++bj) { sc[bj][0] = *(const f32x4*)(scale + col0 + bj * 128); sc[bj][1] = *(const f32x4*)(scale + col0 + bj * 128 + 4); }
#pragma unroll
        for (int ai = 0; ai < 2; ++ai)
#pragma unroll
            for (int m = 0; m < 4; ++m) {
                bf16_t* rowp = act + (size_t)(row0 + ai * 128 + m * 16) * DIN + C_ZB + col0;
#pragma unroll
                for (int bj = 0; bj < 2; ++bj) {
                    const u32x4 z = *(const u32x4*)(rowp + bj * 128);
                    const f32x4 v0 = acc[ai][bj][m][0] * sc[bj][0], v1 = acc[ai][bj][m][1] * sc[bj][1];
                    u32x4 w;
                    w.x = cvt_pk_bf16(v0[0] * bf_lo(z.x), v0[1] * bf_hi(z.x)); w.y = cvt_pk_bf16(v0[2] * bf_lo(z.y), v0[3] * bf_hi(z.y));
                    w.z = cvt_pk_bf16(v1[0] * bf_lo(z.z), v1[1] * bf_hi(z.z)); w.w = cvt_pk_bf16(v1[2] * bf_lo(z.w), v1[3] * bf_hi(z.w));
                    *(u32x4*)(rowp + bj * 128) = w;
                }
                if (m == 3) asm volatile("" ::: "memory");
            }
    }
};

struct EpiMerge {
    static constexpr bool PERM = true, AFTER_DRAIN = false; static constexpr int MID_T = 16;
    bf16_t* act;
    __device__ __forceinline__ void mid(Acc& acc, const Unit& u, int wr, int wc, int fr, int fq) const {
        int row0 = u.pm * 256 + wr * 64 + fr, col0 = u.pn * 256 + wc * 32 + 8 * fq; asm volatile("" : "+v"(row0), "+v"(col0));
#pragma unroll
        for (int ai = 0; ai < 2; ++ai)
#pragma unroll
            for (int m = 0; m < 4; ++m) {
                const bf16_t* rowp = act + (size_t)(row0 + ai * 128 + m * 16) * DIN + col0;
#pragma unroll
                for (int bj = 0; bj < 2; ++bj) {
                    const u32x4 ga = *(const u32x4*)(rowp + C_GA + bj * 128), gb = *(const u32x4*)(rowp + C_GB + bj * 128);
                    f32x4 r0, r1;
                    r0[0] = bf_lo(ga.x) * __builtin_amdgcn_rcpf(fmaxf(bf_lo(gb.x), 1e-30f)); r0[1] = bf_hi(ga.x) * __builtin_amdgcn_rcpf(fmaxf(bf_hi(gb.x), 1e-30f));
                    r0[2] = bf_lo(ga.y) * __builtin_amdgcn_rcpf(fmaxf(bf_lo(gb.y), 1e-30f)); r0[3] = bf_hi(ga.y) * __builtin_amdgcn_rcpf(fmaxf(bf_hi(gb.y), 1e-30f));
                    r1[0] = bf_lo(ga.z) * __builtin_amdgcn_rcpf(fmaxf(bf_lo(gb.z), 1e-30f)); r1[1] = bf_hi(ga.z) * __builtin_amdgcn_rcpf(fmaxf(bf_hi(gb.z), 1e-30f));
                    r1[2] = bf_lo(ga.w) * __builtin_amdgcn_rcpf(fmaxf(bf_lo(gb.w), 1e-30f)); r1[3] = bf_hi(ga.w) * __builtin_amdgcn_rcpf(fmaxf(bf_hi(gb.w), 1e-30f));
                    acc[ai][bj][m][0] *= r0; acc[ai][bj][m][1] *= r1;
                }
                if (m & 1) asm volatile("" ::: "memory");
            }
    }
    __device__ __forceinline__ void operator()(Acc& acc, const Unit& u, int wr, int wc, int fr, int fq) const {
        int row0 = u.pm * 256 + wr * 64 + fr, col0 = u.pn * 256 + wc * 32 + 8 * fq; asm volatile("" : "+v"(row0), "+v"(col0));
#pragma unroll
        for (int ai = 0; ai < 2; ++ai)
#pragma unroll
            for (int m = 0; m < 4; ++m) {
                bf16_t* rowp = act + (size_t)(row0 + ai * 128 + m * 16) * DIN + col0;
#pragma unroll
                for (int bj = 0; bj < 2; ++bj) {
                    const u32x4 gb = *(const u32x4*)(rowp + C_GB + bj * 128);
                    const f32x4 v0 = acc[ai][bj][m][0], v1 = acc[ai][bj][m][1];
                    u32x4 w;
                    w.x = cvt_pk_bf16(v0[0] * bf_lo(gb.x), v0[1] * bf_hi(gb.x)); w.y = cvt_pk_bf16(v0[2] * bf_lo(gb.y), v0[3] * bf_hi(gb.y));
                    w.z = cvt_pk_bf16(v1[0] * bf_lo(gb.z), v1[1] * bf_hi(gb.z)); w.w = cvt_pk_bf16(v1[2] * bf_lo(gb.w), v1[3] * bf_hi(gb.w));
                    *(u32x4*)(rowp + C_M + bj * 128) = w;
                }
                if (m == 3) asm volatile("" ::: "memory");
            }
    }
};

struct EpiOut {
    static constexpr bool PERM = true, AFTER_DRAIN = false; static constexpr int MID_T = -1;
    bf16_t* act; float* statt;
    __device__ __forceinline__ void mid(Acc&, const Unit&, int, int, int, int) const {}
    __device__ __forceinline__ void operator()(Acc& acc, const Unit& u, int wr, int wc, int fr, int fq) const {
        int row0 = u.pm * 256 + wr * 64 + fr, col0 = u.pn * 256 + wc * 32 + 8 * fq; asm volatile("" : "+v"(row0), "+v"(col0));
#pragma unroll
        for (int ai = 0; ai < 2; ++ai)
#pragma unroll
            for (int m = 0; m < 4; ++m) {
                const int row = row0 + ai * 128 + m * 16;
                bf16_t* rowp = act + (size_t)row * DIN + C_T + col0;
                float q = 0.f;
#pragma unroll
                for (int bj = 0; bj < 2; ++bj) {
                    const f32x4 v0 = acc[ai][bj][m][0], v1 = acc[ai][bj][m][1];
                    q += (v0[0] * v0[0] + v0[1] * v0[1]) + (v0[2] * v0[2] + v0[3] * v0[3]) + (v1[0] * v1[0] + v1[1] * v1[1]) + (v1[2] * v1[2] + v1[3] * v1[3]);
                    u32x4 w; w.x = cvt_pk_bf16(v0[0], v0[1]); w.y = cvt_pk_bf16(v0[2], v0[3]); w.z = cvt_pk_bf16(v1[0], v1[1]); w.w = cvt_pk_bf16(v1[2], v1[3]);
                    *(u32x4*)(rowp + bj * 128) = w;
                }
                q += __shfl_xor(q, 16); q += __shfl_xor(q, 32);
                if (fq == 0) statt[(size_t)row * 16 + u.pn * 4 + wc] = q;
            }
    }
};

struct EpiGate {
    static constexpr bool PERM = true, AFTER_DRAIN = false; static constexpr int MID_T = 4;
    bf16_t* act; float* statg;
    __device__ __forceinline__ void mid(Acc& acc, const Unit& u, int wr, int wc, int fr, int fq) const {
        int row0 = u.pm * 256 + wr * 64 + fr, col0 = u.pn * 256 + wc * 32 + 8 * fq; asm volatile("" : "+v"(row0), "+v"(col0));
#pragma unroll
        for (int ai = 0; ai < 2; ++ai)
#pragma unroll
            for (int m = 0; m < 4; ++m) {
                bf16_t* rowp = act + (size_t)(row0 + ai * 128 + m * 16) * DIN + C_E + col0;
#pragma unroll
                for (int bj = 0; bj < 2; ++bj) {
                    const f32x4 v0 = acc[ai][bj][m][0], v1 = acc[ai][bj][m][1];
                    u32x4 w; w.x = cvt_pk_bf16(v0[0], v0[1]); w.y = cvt_pk_bf16(v0[2], v0[3]); w.z = cvt_pk_bf16(v1[0], v1[1]); w.w = cvt_pk_bf16(v1[2], v1[3]);
                    *(u32x4*)(rowp + bj * 128) = w;
                    acc[ai][bj][m][0] = (f32x4){0.f, 0.f, 0.f, 0.f}; acc[ai][bj][m][1] = (f32x4){0.f, 0.f, 0.f, 0.f};
                }
            }
    }
    __device__ __forceinline__ void operator()(Acc& acc, const Unit& u, int wr, int wc, int fr, int fq) const {
        int row0 = u.pm * 256 + wr * 64 + fr, col0 = u.pn * 256 + wc * 32 + 8 * fq; asm volatile("" : "+v"(row0), "+v"(col0));
#pragma unroll
        for (int ai = 0; ai < 2; ++ai)
#pragma unroll
            for (int m = 0; m < 4; ++m) {
                const int row = row0 + ai * 128 + m * 16;
                const bf16_t* erow = act + (size_t)row * DIN + C_E + col0;
                bf16_t* grow = act + (size_t)row * DIN + C_GE + col0;
                float q = 0.f;
#pragma unroll
                for (int bj = 0; bj < 2; ++bj) {
                    const u32x4 e = *(const u32x4*)(erow + bj * 128);
                    const f32x4 a0 = acc[ai][bj][m][0], a1 = acc[ai][bj][m][1];
                    f32x4 v0, v1;
                    v0[0] = sigm(a0[0]) * bf_lo(e.x); v0[1] = sigm(a0[1]) * bf_hi(e.x); v0[2] = sigm(a0[2]) * bf_lo(e.y); v0[3] = sigm(a0[3]) * bf_hi(e.y);
                    v1[0] = sigm(a1[0]) * bf_lo(e.z); v1[1] = sigm(a1[1]) * bf_hi(e.z); v1[2] = sigm(a1[2]) * bf_lo(e.w); v1[3] = sigm(a1[3]) * bf_hi(e.w);
#pragma unroll
                    for (int j = 0; j < 4; ++j) q += v0[j] * v0[j] + v1[j] * v1[j];
                    u32x4 w; w.x = cvt_pk_bf16(v0[0], v0[1]); w.y = cvt_pk_bf16(v0[2], v0[3]); w.z = cvt_pk_bf16(v1[0], v1[1]); w.w = cvt_pk_bf16(v1[2], v1[3]);
                    *(u32x4*)(grow + bj * 128) = w;
                }
                q += __shfl_xor(q, 16); q += __shfl_xor(q, 32);
                if (fq == 0) statg[(size_t)row * 16 + u.pn * 4 + wc] = q;
                asm volatile("" ::: "memory");
            }
    }
};


struct RowX {
    float* xbuf; unsigned* cnt;
    __device__ __forceinline__ void put(int k, float q, int wr, int wc, int fr, int fq, LAS unsigned char* lds) const {
        LAS float* P = (LAS float*)lds;
        q += __shfl_xor(q, 16); q += __shfl_xor(q, 32);
        if (fq == 0) P[((k >> 2) * 128 + wr * 64 + (k & 3) * 16 + fr) * 4 + wc] = q;
    }
    __device__ __forceinline__ void exchange(const Unit& u, LAS unsigned char* lds, int wid, int lane) const {
        LAS float* P = (LAS float*)lds; LAS float* S = (LAS float*)(lds + 4096);
        asm volatile("s_waitcnt lgkmcnt(0)" ::: "memory"); __builtin_amdgcn_s_barrier(); asm volatile("" ::: "memory");
        const int row = wid * 32 + (lane & 31);
        if (lane < 32) {
            const float t = (P[row * 4] + P[row * 4 + 1]) + (P[row * 4 + 2] + P[row * 4 + 3]);
            __hip_atomic_store(xbuf + ((size_t)(u.pm * 256 + row) * 4 + u.pn), t, __ATOMIC_RELAXED, __HIP_MEMORY_SCOPE_AGENT);
        }
        asm volatile("s_waitcnt vmcnt(0)" ::: "memory");
        if (lane == 0) __hip_atomic_fetch_add(cnt + 64 * u.pm, 1u, __ATOMIC_RELAXED, __HIP_MEMORY_SCOPE_AGENT);
        if (wid == 0) {
            unsigned sp = 0;
            while ((unsigned)__builtin_amdgcn_readfirstlane(__hip_atomic_load(cnt + 64 * u.pm, __ATOMIC_RELAXED, __HIP_MEMORY_SCOPE_AGENT)) < 32u) { __builtin_amdgcn_s_sleep(2); if (++sp > (1u << 22)) break; }
            __builtin_amdgcn_fence(__ATOMIC_ACQUIRE, "agent");
        }
        asm volatile("s_waitcnt vmcnt(0) lgkmcnt(0)" ::: "memory"); __builtin_amdgcn_s_barrier(); asm volatile("" ::: "memory");
        if (lane < 32) {
            float* slot = xbuf + (size_t)(u.pm * 256 + row) * 4; float s = 0.f;
#pragma unroll
            for (int t = 0; t < 4; ++t) s += __hip_atomic_load(slot + t, __ATOMIC_RELAXED, __HIP_MEMORY_SCOPE_AGENT);
            S[row] = 1.0f / sqrtf(s * (1.0f / DM) + EPS);
        }
        asm volatile("s_waitcnt lgkmcnt(0)" ::: "memory"); __builtin_amdgcn_s_barrier(); asm volatile("" ::: "memory");
    }
};
struct EpiOutF {
    static constexpr bool PERM = true, AFTER_DRAIN = true; static constexpr int MID_T = -1;
    bf16_t* act; const float* x; float* rstd1g; const float* post_g; const float* ple_in_g; RowX X1, X2;
    __device__ __forceinline__ void mid(Acc&, const Unit&, int, int, int, int) const {}
    __device__ __forceinline__ void operator()(Acc&, const Unit&, int, int, int, int) const {}
    __device__ __forceinline__ void fused(Acc& acc, const Unit& u, int wr, int wc, int fr, int fq, LAS unsigned char* lds, int wid, int lane) const {
        int row0 = u.pm * 256 + wr * 64 + fr, col0 = u.pn * 256 + wc * 32 + 8 * fq; asm volatile("" : "+v"(row0), "+v"(col0));
        const LAS float* S = (const LAS float*)(lds + 4096);
#pragma unroll
        for (int k = 0; k < 8; ++k) { float q = 0.f;
#pragma unroll
            for (int bj = 0; bj < 2; ++bj)
#pragma unroll
                for (int n = 0; n < 2; ++n) { const f32x4 v = acc[k >> 2][bj][k & 3][n]; q += (v[0] * v[0] + v[1] * v[1]) + (v[2] * v[2] + v[3] * v[3]); }
            X1.put(k, q, wr, wc, fr, fq, lds); }
        X1.exchange(u, lds, wid, lane);
#pragma unroll
        for (int k = 0; k < 8; ++k) {
            const int ai = k >> 2, m = k & 3, rl = ai * 128 + wr * 64 + m * 16 + fr; const float rstd = S[rl];
            const unsigned off = (unsigned)((row0 + ai * 128 + m * 16) * DM + col0) * 4u; float q = 0.f;
#pragma unroll
            for (int bj = 0; bj < 2; ++bj)
#pragma unroll
                for (int n = 0; n < 2; ++n) {
                    const f32x4 hv = *(const f32x4*)((const char*)x + off + (bj * 128 + 4 * n) * 4), gv = *(const f32x4*)(post_g + col0 + bj * 128 + 4 * n);
                    const f32x4 h1 = hv + acc[ai][bj][m][n] * rstd * gv;
                    acc[ai][bj][m][n] = h1; q += (h1[0] * h1[0] + h1[1] * h1[1]) + (h1[2] * h1[2] + h1[3] * h1[3]);
                }
            X2.put(k, q, wr, wc, fr, fq, lds + 8192);
            asm volatile("" : "+v"(acc[ai][0][m][0]), "+v"(acc[ai][0][m][1]), "+v"(acc[ai][1][m][0]), "+v"(acc[ai][1][m][1]));
            if (k & 1) asm volatile("" ::: "memory");
        }
        X2.exchange(u, lds + 8192, wid, lane);
        const LAS float* S2 = (const LAS float*)(lds + 8192 + 4096);
        if (u.pn == 0 && lane < 32) rstd1g[u.pm * 256 + wid * 32 + lane] = S2[wid * 32 + lane];
#pragma unroll
        for (int k = 0; k < 8; ++k) {
            const int ai = k >> 2, m = k & 3, rl = ai * 128 + wr * 64 + m * 16 + fr; const float rstd1 = S2[rl];
            const unsigned off = (unsigned)((row0 + ai * 128 + m * 16) * DIN + PLE + col0) * 2u;
#pragma unroll
            for (int bj = 0; bj < 2; ++bj) {
                const f32x4 g0 = *(const f32x4*)(ple_in_g + col0 + bj * 128), g1 = *(const f32x4*)(ple_in_g + col0 + bj * 128 + 4);
                const f32x4 v0 = acc[ai][bj][m][0] * rstd1 * g0, v1 = acc[ai][bj][m][1] * rstd1 * g1;
                u32x4 w; w.x = cvt_pk_bf16(v0[0], v0[1]); w.y = cvt_pk_bf16(v0[2], v0[3]); w.z = cvt_pk_bf16(v1[0], v1[1]); w.w = cvt_pk_bf16(v1[2], v1[3]);
                *(u32x4*)((char*)act + off + bj * 256) = w;
            }
            if ((k & 3) == 3) asm volatile("" ::: "memory");
        }
    }
};
struct EpiGateF {
    static constexpr bool PERM = true, AFTER_DRAIN = true; static constexpr int MID_T = 4;
    bf16_t* act; float* out; const float* g; const float* gin; const float* rstd1g; RowX X;
    __device__ __forceinline__ void operator()(Acc&, const Unit&, int, int, int, int) const {}
    __device__ __forceinline__ void mid(Acc& acc, const Unit& u, int wr, int wc, int fr, int fq) const {
        int row0 = u.pm * 256 + wr * 64 + fr, col0 = u.pn * 256 + wc * 32 + 8 * fq; asm volatile("" : "+v"(row0), "+v"(col0));
#pragma unroll
        for (int ai = 0; ai < 2; ++ai)
#pragma unroll
            for (int m = 0; m < 4; ++m) {
                bf16_t* rowp = act + (size_t)(row0 + ai * 128 + m * 16) * DIN + C_E + col0;
#pragma unroll
                for (int bj = 0; bj < 2; ++bj) {
                    const f32x4 v0 = acc[ai][bj][m][0], v1 = acc[ai][bj][m][1];
                    u32x4 w; w.x = cvt_pk_bf16(v0[0], v0[1]); w.y = cvt_pk_bf16(v0[2], v0[3]); w.z = cvt_pk_bf16(v1[0], v1[1]); w.w = cvt_pk_bf16(v1[2], v1[3]);
                    *(u32x4*)(rowp + bj * 128) = w;
                    acc[ai][bj][m][0] = (f32x4){0.f, 0.f, 0.f, 0.f}; acc[ai][bj][m][1] = (f32x4){0.f, 0.f, 0.f, 0.f};
                }
            }
    }
    __device__ __forceinline__ void fused(Acc& acc, const Unit& u, int wr, int wc, int fr, int fq, LAS unsigned char* lds, int wid, int lane) const {
        int row0 = u.pm * 256 + wr * 64 + fr, col0 = u.pn * 256 + wc * 32 + 8 * fq; asm volatile("" : "+v"(row0), "+v"(col0));
        const LAS float* S = (const LAS float*)(lds + 4096);
#pragma unroll
        for (int k = 0; k < 8; ++k) {
            const int ai = k >> 2, m = k & 3;
            const unsigned eoff = (unsigned)((row0 + ai * 128 + m * 16) * DIN + C_E + col0) * 2u; float q = 0.f;
#pragma unroll
            for (int bj = 0; bj < 2; ++bj) {
                const u32x4 e = *(const u32x4*)((const char*)act + eoff + bj * 256);
                const f32x4 a0 = acc[ai][bj][m][0], a1 = acc[ai][bj][m][1];
                f32x4 v0, v1;
                v0[0] = sigm(a0[0]) * bf_lo(e.x); v0[1] = sigm(a0[1]) * bf_hi(e.x); v0[2] = sigm(a0[2]) * bf_lo(e.y); v0[3] = sigm(a0[3]) * bf_hi(e.y);
                v1[0] = sigm(a1[0]) * bf_lo(e.z); v1[1] = sigm(a1[1]) * bf_hi(e.z); v1[2] = sigm(a1[2]) * bf_lo(e.w); v1[3] = sigm(a1[3]) * bf_hi(e.w);
#pragma unroll
                for (int j = 0; j < 4; ++j) q += v0[j] * v0[j] + v1[j] * v1[j];
                acc[ai][bj][m][0] = v0; acc[ai][bj][m][1] = v1;
            }
            X.put(k, q, wr, wc, fr, fq, lds);
            asm volatile("" : "+v"(acc[ai][0][m][0]), "+v"(acc[ai][0][m][1]), "+v"(acc[ai][1][m][0]), "+v"(acc[ai][1][m][1]));
            if (k & 1) asm volatile("" ::: "memory");
        }
        X.exchange(u, lds, wid, lane);
        f32x4 ig[2][2];
#pragma unroll
        for (int bj = 0; bj < 2; ++bj)
#pragma unroll
            for (int n = 0; n < 2; ++n) { const f32x4 gi = *(const f32x4*)(gin + col0 + bj * 128 + 4 * n);
                ig[bj][n] = (f32x4){__builtin_amdgcn_rcpf(gi[0]), __builtin_amdgcn_rcpf(gi[1]), __builtin_amdgcn_rcpf(gi[2]), __builtin_amdgcn_rcpf(gi[3])}; }
#pragma unroll
        for (int k = 0; k < 8; ++k) {
            const int ai = k >> 2, m = k & 3, rl = ai * 128 + wr * 64 + m * 16 + fr; const float rstd = S[rl];
            const int row = row0 + ai * 128 + m * 16;
            const float ir1 = __builtin_amdgcn_rcpf(rstd1g[row]);
            const unsigned off = (unsigned)(row * DM + col0) * 4u, hoff = (unsigned)(row * DIN + PLE + col0) * 2u;
#pragma unroll
            for (int bj = 0; bj < 2; ++bj) {
                const u32x4 hn = *(const u32x4*)((const char*)act + hoff + bj * 256);
                const f32x4 h0 = (f32x4){bf_lo(hn.x), bf_hi(hn.x), bf_lo(hn.y), bf_hi(hn.y)} * ig[bj][0] * ir1, h1v = (f32x4){bf_lo(hn.z), bf_hi(hn.z), bf_lo(hn.w), bf_hi(hn.w)} * ig[bj][1] * ir1;
                const f32x4 g0 = *(const f32x4*)(g + col0 + bj * 128), g1 = *(const f32x4*)(g + col0 + bj * 128 + 4);
                *(f32x4*)((char*)out + off + (bj * 128) * 4) = h0 + acc[ai][bj][m][0] * rstd * g0;
                *(f32x4*)((char*)out + off + (bj * 128 + 4) * 4) = h1v + acc[ai][bj][m][1] * rstd * g1;
            }
            if (k & 1) asm volatile("" ::: "memory");
        }
    }
};

template <int NT>
__device__ __forceinline__ void small_gemm1(const Params& p, const bf16_t* A, int lda, const bf16_t* Bt, int ldb, int K, int nstrips) {
    const int tid = threadIdx.x, lane = tid & 63, wid = __builtin_amdgcn_readfirstlane(tid >> 6), fr = lane & 15, fq = lane >> 4;
    bf16_t* act = (bf16_t*)(p.ws + WS_ACT);
    for (int u = blockIdx.x; u < nstrips; u += gridDim.x) {
        const int n0 = u * 16 * NT, r = wid * 16 + fr, row = MPR + r;
        const bf16_t* ap = A + (size_t)row * lda + 8 * fq;
        const bf16_t* bp = Bt + (size_t)(n0 + fr) * ldb + 8 * fq;
        bf16_t* arow = act + (size_t)row * DIN;
        f32x4 acc[NT];
#pragma unroll
        for (int t = 0; t < NT; ++t) acc[t] = (f32x4){0.f, 0.f, 0.f, 0.f};
        for (int k0 = 0; k0 < K; k0 += 256) {
            bf16x8 a[8], b[NT][8];
#pragma unroll
            for (int j = 0; j < 8; ++j) { a[j] = *(const bf16x8*)(ap + k0 + 32 * j);
#pragma unroll
                for (int t = 0; t < NT; ++t) b[t][j] = *(const bf16x8*)(bp + (size_t)t * 16 * ldb + k0 + 32 * j); }
#pragma unroll
            for (int j = 0; j < 8; ++j)
#pragma unroll
                for (int t = 0; t < NT; ++t) acc[t] = __builtin_amdgcn_mfma_f32_16x16x32_bf16(b[t][j], a[j], acc[t], 0, 0, 0);
        }
#pragma unroll
        for (int t = 0; t < NT; ++t) {
            const int nt0 = n0 + 16 * t, col = nt0 + 4 * fq, blk = nt0 >> 10; f32x4 v = acc[t];
            if (blk == 2) { v[0] = gelu_t(v[0]); v[1] = gelu_t(v[1]); v[2] = gelu_t(v[2]); v[3] = gelu_t(v[3]); }
            else if (blk == 1) { v[0] *= sigm(v[0]); v[1] *= sigm(v[1]); v[2] *= sigm(v[2]); v[3] *= sigm(v[3]); }
            else if (blk >= 5) { v[0] = sigm(v[0]); v[1] = sigm(v[1]); v[2] = sigm(v[2]); v[3] = sigm(v[3]); }
            u32x2 w; w.x = cvt_pk_bf16(v[0], v[1]); w.y = cvt_pk_bf16(v[2], v[3]);
            *(u32x2*)(arow + col) = w;
            if (blk == 2) {
                float s = (v[0] + v[1]) + (v[2] + v[3]), q = (v[0] * v[0] + v[1] * v[1]) + (v[2] * v[2] + v[3] * v[3]);
                s += __shfl_xor(s, 16); s += __shfl_xor(s, 32); q += __shfl_xor(q, 16); q += __shfl_xor(q, 32);
                if (fq == 0) *(f32x2*)((float*)(p.ws + WS_SVS) + ((size_t)r * 64 + ((nt0 & 1023) >> 4)) * 2) = (f32x2){s, q};
            }
            if (blk == 4) *(f32x4*)(p.out + O_SP + ((size_t)r * 15 + 14) * DM + (col & 1023)) = v;
        }
    }
}

template <int MODE>
__device__ __forceinline__ void small2(LAS unsigned char* lds, const Params& p, const bf16_t* A, int lda, const bf16_t* Bt, int ldb) {
    const int tid = threadIdx.x, lane = tid & 63, wid = __builtin_amdgcn_readfirstlane(tid >> 6), fr = lane & 15, fq = lane >> 4, rt = wid & 1, kq = wid >> 1;
    bf16_t* act = (bf16_t*)(p.ws + WS_ACT);
    LAS f32x4* red = (LAS f32x4*)lds;
    for (int u = blockIdx.x; u < 256; u += gridDim.x) {
        const int strip = u & 63, n0 = strip * 16, r = (u >> 6) * 32 + rt * 16 + fr, row = MPR + r, col = n0 + 4 * fq;
        const bf16_t* ap = A + (size_t)row * lda + 8 * fq + (MODE == 2 ? (n0 >> 8) * 256 : 0);
        const bf16_t* bp = Bt + (size_t)(n0 + fr) * ldb + 8 * fq;
        bf16_t* arow = act + (size_t)row * DIN;
        f32x4 acc = (f32x4){0.f, 0.f, 0.f, 0.f}, e4 = (f32x4){0.f, 0.f, 0.f, 0.f};
        if (MODE == 2) {
            bf16x8 a[2], b[2];
#pragma unroll
            for (int j = 0; j < 2; ++j) { a[j] = *(const bf16x8*)(ap + kq * 64 + 32 * j); b[j] = *(const bf16x8*)(bp + kq * 64 + 32 * j); }
#pragma unroll
            for (int j = 0; j < 2; ++j) acc = __builtin_amdgcn_mfma_f32_16x16x32_bf16(b[j], a[j], acc, 0, 0, 0);
        } else {
            constexpr int NB = MODE == 3 ? 2 : 1;
            const int kbase = MODE == 3 ? kq * 512 : MODE == 4 ? kq * 256 : 256 + kq * 256;
            if (MODE == 6 && kq == 0) {
                bf16x8 a[8], b[8];
#pragma unroll
                for (int j = 0; j < 8; ++j) { a[j] = *(const bf16x8*)(ap + 32 * j); b[j] = *(const bf16x8*)(bp + 32 * j); }
#pragma unroll
                for (int j = 0; j < 8; ++j) e4 = __builtin_amdgcn_mfma_f32_16x16x32_bf16(b[j], a[j], e4, 0, 0, 0);
            }
#pragma unroll
            for (int bt = 0; bt < NB; ++bt) {
                bf16x8 a[8], b[8];
#pragma unroll
                for (int j = 0; j < 8; ++j) { a[j] = *(const bf16x8*)(ap + kbase + bt * 256 + 32 * j); b[j] = *(const bf16x8*)(bp + kbase + bt * 256 + 32 * j); }
#pragma unroll
                for (int j = 0; j < 8; ++j) acc = __builtin_amdgcn_mfma_f32_16x16x32_bf16(b[j], a[j], acc, 0, 0, 0);
            }
        }
        red[wid * 64 + lane] = acc;
        __syncthreads();
        if (kq == 0) {
            const f32x4 p1 = red[(rt + 2) * 64 + lane], p2 = red[(rt + 4) * 64 + lane], p3 = red[(rt + 6) * 64 + lane];
            f32x4 v;
            if (MODE == 3) {
                const u32x2 ga = *(const u32x2*)(arow + C_GA + col), gb = *(const u32x2*)(arow + C_GB + col);
                const f32x4 ya = acc + p1, yb = p2 + p3;
                v[0] = ya[0] * bf_lo(ga.x) + yb[0] * bf_lo(gb.x); v[1] = ya[1] * bf_hi(ga.x) + yb[1] * bf_hi(gb.x);
                v[2] = ya[2] * bf_lo(ga.y) + yb[2] * bf_lo(gb.y); v[3] = ya[3] * bf_hi(ga.y) + yb[3] * bf_hi(gb.y);
                u32x2 w; w.x = cvt_pk_bf16(v[0], v[1]); w.y = cvt_pk_bf16(v[2], v[3]);
                *(u32x2*)(arow + C_M + col) = w;
            } else {
                v = (acc + p1) + (p2 + p3);
                if (MODE == 2) {
                    const u32x2 z = *(const u32x2*)(arow + C_ZB + col); const f32x4 sc = *(const f32x4*)(p.pool_scale + col);
                    u32x2 w; w.x = cvt_pk_bf16(v[0] * sc[0] * bf_lo(z.x), v[1] * sc[1] * bf_hi(z.x)); w.y = cvt_pk_bf16(v[2] * sc[2] * bf_lo(z.y), v[3] * sc[3] * bf_hi(z.y));
                    *(u32x2*)(arow + C_ZB + col) = w;
                } else {
                    if (MODE == 6) { v[0] = sigm(v[0]) * e4[0]; v[1] = sigm(v[1]) * e4[1]; v[2] = sigm(v[2]) * e4[2]; v[3] = sigm(v[3]) * e4[3]; }
                    { u32x2 w; w.x = cvt_pk_bf16(v[0], v[1]); w.y = cvt_pk_bf16(v[2], v[3]); *(u32x2*)(arow + (MODE == 4 ? C_T : C_GE) + col) = w; }
                    float q = (v[0] * v[0] + v[1] * v[1]) + (v[2] * v[2] + v[3] * v[3]);
                    q += __shfl_xor(q, 16); q += __shfl_xor(q, 32);
                    if (fq == 0) ((float*)(p.ws + (MODE == 4 ? WS_STS : WS_SGS)))[(size_t)r * 64 + strip] = q;
                }
            }
        }
        __syncthreads();
    }
}

template <int MODE> struct PreSmall2 {
    LAS unsigned char* lds; const Params& p; const bf16_t* A; int lda; const bf16_t* Bt; int ldb;
    __device__ __forceinline__ void operator()() const { small2<MODE>(lds + 131072 + 64, p, A, lda, Bt, ldb); }
};

__device__ __forceinline__ void transpose_tile(LAS unsigned char* lds, const float* src, int lds_src, int k0, int n0, bf16_t* dst, int ldd, int drow0, int dcol0) {
    LAS bf16_t* T = (LAS bf16_t*)lds;
    const int tid = threadIdx.x;
#pragma unroll
    for (int i = 0; i < 2; ++i) {
        const int r = (tid >> 4) + 32 * i, c4 = (tid & 15) * 4;
        const f32x4 v = *(const f32x4*)(src + (size_t)(k0 + r) * lds_src + n0 + c4);
        const unsigned p01 = cvt_pk_bf16(v[0], v[1]), p23 = cvt_pk_bf16(v[2], v[3]);
        T[(c4 + 0) * 72 + r] = (bf16_t)(p01 & 0xffffu); T[(c4 + 1) * 72 + r] = (bf16_t)(p01 >> 16);
        T[(c4 + 2) * 72 + r] = (bf16_t)(p23 & 0xffffu); T[(c4 + 3) * 72 + r] = (bf16_t)(p23 >> 16);
    }
    __syncthreads();
    {
        const int n = tid >> 3, kc = (tid & 7) * 8;
        const u32x4 w = *(const LAS u32x4*)(T + n * 72 + kc);
        *(u32x4*)(dst + (size_t)(drow0 + n) * ldd + dcol0 + kc) = w;
    }
    __syncthreads();
}

__device__ __forceinline__ void phase_prep(LAS unsigned char* lds, const Params& p) {
    const int tid = threadIdx.x, lane = tid & 63, wid = tid >> 6, G = gridDim.x, bid = blockIdx.x;
    bf16_t* XN = (bf16_t*)((unsigned char*)p.out + DO_XN);
    bf16_t* WinT = (bf16_t*)((unsigned char*)p.out + DO_WIN);
    bf16_t* WcatT = (bf16_t*)(p.ws + WS_WCAT); bf16_t* WoutT = (bf16_t*)(p.ws + WS_WOUT); bf16_t* W6T = (bf16_t*)(p.ws + WS_W6);
    bf16_t* WpoolT = (bf16_t*)(p.ws + WS_WPOOL); bf16_t* WsB = (bf16_t*)(p.ws + WS_WS);
    for (int row = bid * 8 + wid; row < MREAL; row += G * 8) {
        bf16_t* dst = XN + (size_t)row * DM;
        const float* src = row < MPR ? p.x_prompt + (size_t)row * DM : p.x_sample + (size_t)(row - MPR) * DM;
        f32x4 v[4]; float ss = 0.f;
#pragma unroll
        for (int i = 0; i < 4; ++i) { v[i] = *(const f32x4*)(src + lane * 4 + 256 * i); ss += (v[i][0] * v[i][0] + v[i][1] * v[i][1]) + (v[i][2] * v[i][2] + v[i][3] * v[i][3]); }
        ss = wave_sum(ss);
        const float rstd = 1.0f / sqrtf(ss * (1.0f / DM) + EPS);
#pragma unroll
        for (int i = 0; i < 4; ++i) {
            const f32x4 g = *(const f32x4*)(p.pre_g + lane * 4 + 256 * i);
            u32x2 w; w.x = cvt_pk_bf16(v[i][0] * rstd * g[0], v[i][1] * rstd * g[1]); w.y = cvt_pk_bf16(v[i][2] * rstd * g[2], v[i][3] * rstd * g[3]);
            *(u32x2*)(dst + lane * 4 + 256 * i) = w;
        }
    }
    constexpr int T_IN = 16 * 112, T_SQ = 256, T_PLE = 64, T_POOL = 64, T_ALL = T_IN + 4 * T_SQ + T_PLE + T_POOL;
    for (int it = bid; it < T_ALL; it += G) {
        int r = it;
        if (r < T_IN) {
            const int kt = r / 112, ntile = r % 112, n0 = ntile * 64, sb = n0 >> 10;
            const int db = sb == 0 ? 0 : sb == 1 ? 2 : sb == 2 ? 3 : sb == 3 ? 4 : sb == 4 ? 1 : sb;
            transpose_tile(lds, p.w_in, DIN, kt * 64, n0, WinT, DM, db * 1024 + (n0 & 1023), kt * 64); continue; }
        r -= T_IN;
        if (r < T_SQ) { transpose_tile(lds, p.w_pa, DM, (r >> 4) * 64, (r & 15) * 64, WcatT, 2048, (r & 15) * 64, (r >> 4) * 64); continue; } r -= T_SQ;
        if (r < T_SQ) { transpose_tile(lds, p.w_pb, DM, (r >> 4) * 64, (r & 15) * 64, WcatT, 2048, (r & 15) * 64, 1024 + (r >> 4) * 64); continue; } r -= T_SQ;
        if (r < T_SQ) { transpose_tile(lds, p.w_out, DM, (r >> 4) * 64, (r & 15) * 64, WoutT, 1024, (r & 15) * 64, (r >> 4) * 64); continue; } r -= T_SQ;
        if (r < T_SQ) { transpose_tile(lds, p.w_pg, DM, (r >> 4) * 64, (r & 15) * 64, W6T, 1280, (r & 15) * 64, 256 + (r >> 4) * 64); continue; } r -= T_SQ;
        if (r < T_PLE) { transpose_tile(lds, p.w_ple, DM, (r >> 4) * 64, (r & 15) * 64, W6T, 1280, (r & 15) * 64, (r >> 4) * 64); continue; } r -= T_PLE;
        { const int g = r >> 4, q = r & 15; transpose_tile(lds, p.w_pool + (size_t)g * 65536, 256, (q >> 2) * 64, (q & 3) * 64, WpoolT + (size_t)g * 65536, 256, (q & 3) * 64, (q >> 2) * 64); }
    }
    const int nb2 = (G == 256) ? 128 : G, b2 = (G == 256) ? bid - 128 : bid;
    if (b2 >= 0) for (int i = b2 * NTHR + tid; i < 8 * 128 * 128 / 4; i += nb2 * NTHR) {
        const int e = i * 4, t = (e >> 7) & 127, s = e & 127;
        const f32x4 v = *(const f32x4*)(p.w_s + e);
        u32x2 w; w.x = cvt_pk_bf16(s + 0 <= t ? v[0] : 0.f, s + 1 <= t ? v[1] : 0.f); w.y = cvt_pk_bf16(s + 2 <= t ? v[2] : 0.f, s + 3 <= t ? v[3] : 0.f);
        *(u32x2*)(WsB + e) = w;
    }
    if (b2 >= 0) for (int i = b2 * NTHR + tid; i < MSM * 14 * DM / 4; i += nb2 * NTHR) {
        const int e = i * 4, b = e / (14 * DM), rem = e % (14 * DM);
        *(f32x4*)(p.out + O_SP + (size_t)b * 15 * DM + rem) = *(const f32x4*)(p.state_pool + (size_t)b * 15 * DM + DM + rem);
    }
}

__device__ __forceinline__ void mix_unit(LAS unsigned char* lds, const Params& p, int c, int h, bool load_w) {
    const int tid = threadIdx.x, lane = tid & 63, wid = __builtin_amdgcn_readfirstlane(tid >> 6), fr = lane & 15, fq = lane >> 4;
    bf16_t* act = (bf16_t*)(p.ws + WS_ACT);
    const float* statv = (const float*)(p.ws + WS_STATV);
    const bf16_t* WsB = (const bf16_t*)(p.ws + WS_WS);
    constexpr int SW = 136, SV = 136;
    LAS bf16_t* Wt = (LAS bf16_t*)lds;
    LAS bf16_t* Vt = (LAS bf16_t*)(lds + 128 * SW * 2);
    LAS float* St = (LAS float*)(lds + 128 * SW * 2 + 128 * SV * 2);
    const int R0 = c * 128, C0 = h * 128, wt = wid >> 1, wd = wid & 1;
    u32x4 wreg[4];
    if (load_w) {
#pragma unroll
        for (int i = 0; i < 4; ++i) { const int idx = tid + i * NTHR, t = idx >> 4, sc = idx & 15; wreg[i] = *(const u32x4*)(WsB + ((size_t)h * 128 + t) * 128 + sc * 8); }
    }
    const f32x4 sv0 = *(const f32x4*)(statv + (size_t)(R0 + (tid >> 2)) * 32 + (tid & 3) * 8), sv1 = *(const f32x4*)(statv + (size_t)(R0 + (tid >> 2)) * 32 + (tid & 3) * 8 + 4);
    u32x4 ra[2], rb[2]; f32x4 lg0[2], lg1[2], lb0[2], lb1[2];
#pragma unroll
    for (int i = 0; i < 2; ++i) {
        const int idx = tid + i * NTHR, sp2 = idx & 63, dc = idx >> 6, s0 = sp2 * 2, d0 = dc * 8;
        ra[i] = *(const u32x4*)(act + (size_t)(R0 + s0) * DIN + C_V + C0 + d0); rb[i] = *(const u32x4*)(act + (size_t)(R0 + s0 + 1) * DIN + C_V + C0 + d0);
        lg0[i] = *(const f32x4*)(p.ln_g + C0 + d0); lg1[i] = *(const f32x4*)(p.ln_g + C0 + d0 + 4); lb0[i] = *(const f32x4*)(p.ln_b + C0 + d0); lb1[i] = *(const f32x4*)(p.ln_b + C0 + d0 + 4);
    }
    u32x2 uu[2][4], za[2][4]; float bs[2];
#pragma unroll
    for (int i = 0; i < 2; ++i) {
        const int t = 32 * wt + 16 * i + fr; bs[i] = p.b_s[h * 128 + t];
        const bf16_t* rowp = act + (size_t)(R0 + t) * DIN + C0 + 64 * wd + 4 * fq;
#pragma unroll
        for (int j = 0; j < 4; ++j) { uu[i][j] = *(const u32x2*)(rowp + C_U + 16 * j); za[i][j] = *(const u32x2*)(rowp + C_ZA + 16 * j); }
    }
    if (load_w) {
#pragma unroll
        for (int i = 0; i < 4; ++i) { const int idx = tid + i * NTHR, t = idx >> 4, sc = idx & 15; *(LAS u32x4*)(Wt + t * SW + sc * 8) = wreg[i]; }
    }
    {
        float s = (sv0[0] + sv0[2]) + (sv1[0] + sv1[2]), q = (sv0[1] + sv0[3]) + (sv1[1] + sv1[3]);
        s += __shfl_xor(s, 1); q += __shfl_xor(q, 1); s += __shfl_xor(s, 2); q += __shfl_xor(q, 2);
        if ((tid & 3) == 0) { const float mean = s * (1.0f / DM), var = fmaxf(q * (1.0f / DM) - mean * mean, 0.f); St[(tid >> 2) * 2] = mean; St[(tid >> 2) * 2 + 1] = 1.0f / sqrtf(var + EPS); }
    }
    __syncthreads();
    const bool last_chunk = (c & 15) == 15;
#pragma unroll
    for (int i = 0; i < 2; ++i) {
        const int idx = tid + i * NTHR, sp2 = idx & 63, dc = idx >> 6, s0 = sp2 * 2, d0 = dc * 8;
        const float ma = St[s0 * 2], ia = St[s0 * 2 + 1], mb = St[s0 * 2 + 2], ib = St[s0 * 2 + 3];
        const f32x4 g0 = lg0[i], g1 = lg1[i], b0 = lb0[i], b1 = lb1[i]; const u32x4 xa = ra[i], xb = rb[i];
        f32x4 a0, a1, c0, c1;
        a0[0] = (bf_lo(xa.x) - ma) * ia * g0[0] + b0[0]; a0[1] = (bf_hi(xa.x) - ma) * ia * g0[1] + b0[1]; a0[2] = (bf_lo(xa.y) - ma) * ia * g0[2] + b0[2]; a0[3] = (bf_hi(xa.y) - ma) * ia * g0[3] + b0[3];
        a1[0] = (bf_lo(xa.z) - ma) * ia * g1[0] + b1[0]; a1[1] = (bf_hi(xa.z) - ma) * ia * g1[1] + b1[1]; a1[2] = (bf_lo(xa.w) - ma) * ia * g1[2] + b1[2]; a1[3] = (bf_hi(xa.w) - ma) * ia * g1[3] + b1[3];
        c0[0] = (bf_lo(xb.x) - mb) * ib * g0[0] + b0[0]; c0[1] = (bf_hi(xb.x) - mb) * ib * g0[1] + b0[1]; c0[2] = (bf_lo(xb.y) - mb) * ib * g0[2] + b0[2]; c0[3] = (bf_hi(xb.y) - mb) * ib * g0[3] + b0[3];
        c1[0] = (bf_lo(xb.z) - mb) * ib * g1[0] + b1[0]; c1[1] = (bf_hi(xb.z) - mb) * ib * g1[1] + b1[1]; c1[2] = (bf_lo(xb.w) - mb) * ib * g1[2] + b1[2]; c1[3] = (bf_hi(xb.w) - mb) * ib * g1[3] + b1[3];
        if (last_chunk) {
            float* o = p.out + O_PCV + ((size_t)(c >> 4) * 128 + s0) * DM + C0 + d0;
            *(f32x4*)o = a0; *(f32x4*)(o + 4) = a1; *(f32x4*)(o + DM) = c0; *(f32x4*)(o + DM + 4) = c1;
        }
        LAS unsigned* vp = (LAS unsigned*)(Vt + d0 * SV + s0);
#pragma unroll
        for (int j = 0; j < 4; ++j) { vp[(j * SV) / 2] = cvt_pk_bf16(a0[j], c0[j]); vp[((4 + j) * SV) / 2] = cvt_pk_bf16(a1[j], c1[j]); }
    }
    __syncthreads();
    f32x4 acc[2][4];
#pragma unroll
    for (int i = 0; i < 2; ++i)
#pragma unroll
        for (int j = 0; j < 4; ++j) acc[i][j] = (f32x4){0.f, 0.f, 0.f, 0.f};
    for (int ks = 0; ks <= wt; ++ks) {
        bf16x8 af[2], bfr[4];
#pragma unroll
        for (int i = 0; i < 2; ++i) af[i] = *(const LAS bf16x8*)(Wt + (32 * wt + 16 * i + fr) * SW + 32 * ks + 8 * fq);
#pragma unroll
        for (int j = 0; j < 4; ++j) bfr[j] = *(const LAS bf16x8*)(Vt + (64 * wd + 16 * j + fr) * SV + 32 * ks + 8 * fq);
#pragma unroll
        for (int i = 0; i < 2; ++i)
#pragma unroll
            for (int j = 0; j < 4; ++j) acc[i][j] = __builtin_amdgcn_mfma_f32_16x16x32_bf16(bfr[j], af[i], acc[i][j], 0, 0, 0);
    }
#pragma unroll
    for (int i = 0; i < 2; ++i) {
        const int t = 32 * wt + 16 * i + fr;
        bf16_t* rowp = act + (size_t)(R0 + t) * DIN + C0 + 64 * wd + 4 * fq;
#pragma unroll
        for (int j = 0; j < 4; ++j) {
            const u32x2 u2 = uu[i][j], z2v = za[i][j];
            const f32x4 a = acc[i][j]; const float b = bs[i];
            const float z0 = bf_lo(z2v.x), z1 = bf_hi(z2v.x), z2 = bf_lo(z2v.y), z3 = bf_hi(z2v.y);
            u32x2 w; w.x = cvt_pk_bf16(gelu_t(bf_lo(u2.x)) * (a[0] + b) * (z0 * sigm(z0)), gelu_t(bf_hi(u2.x)) * (a[1] + b) * (z1 * sigm(z1)));
            w.y = cvt_pk_bf16(gelu_t(bf_lo(u2.y)) * (a[2] + b) * (z2 * sigm(z2)), gelu_t(bf_hi(u2.y)) * (a[3] + b) * (z3 * sigm(z3)));
            *(u32x2*)(rowp + C_U + 16 * j) = w;
        }
    }
    __syncthreads();
}

template <int W>
__device__ __forceinline__ void qpass_strip(const bf16_t* act, bf16_t* Q, int i0, int colg) {
    constexpr int NR = W + 7;
    const int pos0 = i0 & (SEQ - 1);
    const bf16_t* xcol = act + C_XB + colg;
    u32x4 xr[NR];
#pragma unroll
    for (int k = 0; k < NR; ++k) {
        const int d = k - (W - 1);
        if (pos0 + d >= 0) xr[k] = *(const u32x4*)(xcol + (size_t)(i0 + d) * DIN); else xr[k] = (u32x4){0u, 0u, 0u, 0u};
    }
    float S[8];
#pragma unroll
    for (int j = 0; j < 8; ++j) S[j] = 0.f;
#pragma unroll
    for (int k = 0; k < W - 1; ++k) { S[0] += bf_lo(xr[k].x); S[1] += bf_hi(xr[k].x); S[2] += bf_lo(xr[k].y); S[3] += bf_hi(xr[k].y); S[4] += bf_lo(xr[k].z); S[5] += bf_hi(xr[k].z); S[6] += bf_lo(xr[k].w); S[7] += bf_hi(xr[k].w); }
#pragma unroll
    for (int i = 0; i < 8; ++i) {
        const u32x4 x = xr[W - 1 + i], y = xr[i];
        const float xv[8] = {bf_lo(x.x), bf_hi(x.x), bf_lo(x.y), bf_hi(x.y), bf_lo(x.z), bf_hi(x.z), bf_lo(x.w), bf_hi(x.w)};
        const float yv[8] = {bf_lo(y.x), bf_hi(y.x), bf_lo(y.y), bf_hi(y.y), bf_lo(y.z), bf_hi(y.z), bf_lo(y.w), bf_hi(y.w)};
        const int pos = pos0 + i; const float ic = pos + 1 < W ? 1.0f / (float)(pos + 1) : 1.0f / (float)W;
        float qv[8];
#pragma unroll
        for (int j = 0; j < 8; ++j) { S[j] += xv[j]; qv[j] = S[j] * ic - xv[j]; S[j] -= yv[j]; }
        u32x4 o; o.x = cvt_pk_bf16(qv[0], qv[1]); o.y = cvt_pk_bf16(qv[2], qv[3]); o.z = cvt_pk_bf16(qv[4], qv[5]); o.w = cvt_pk_bf16(qv[6], qv[7]);
        *(u32x4*)(Q + (size_t)(i0 + i) * DM + colg) = o;
    }
}
__device__ __forceinline__ void phase_qpass(const Params& p) {
    const int tid = threadIdx.x, lane = tid & 63, wid = __builtin_amdgcn_readfirstlane(tid >> 6), G = gridDim.x, bid = blockIdx.x;
    const bf16_t* act = (const bf16_t*)(p.ws + WS_ACT);
    bf16_t* Q = (bf16_t*)((unsigned char*)p.out + DO_XN);
    const int g = wid & 3, strip = (wid >> 2) * 2 + (lane >> 5), colg = g * 256 + (lane & 31) * 8;
    for (int blk = bid; blk < MPR / 32; blk += G) {
        const int i0 = blk * 32 + strip * 8;
        if (g == 0) qpass_strip<2>(act, Q, i0, colg); else if (g == 1) qpass_strip<4>(act, Q, i0, colg); else if (g == 2) qpass_strip<8>(act, Q, i0, colg); else qpass_strip<16>(act, Q, i0, colg);
    }
    if (wid == 1) for (int it = bid * 64 + lane; it < MSM * 128; it += G * 64) {
        const int i = it >> 7, c8 = (it & 127) * 8, w = 2 << (c8 >> 8);
        const u32x4 x = *(const u32x4*)(act + (size_t)(MPR + i) * DIN + C_XB + c8);
        const float xv[8] = {bf_lo(x.x), bf_hi(x.x), bf_lo(x.y), bf_hi(x.y), bf_lo(x.z), bf_hi(x.z), bf_lo(x.w), bf_hi(x.w)};
        float S[8];
#pragma unroll
        for (int j = 0; j < 8; ++j) S[j] = xv[j];
        const float* sp = p.state_pool + (size_t)i * 15 * DM + c8;
#pragma unroll
        for (int j = 1; j < 16; ++j) {
            const f32x4 h0 = *(const f32x4*)(sp + (size_t)(15 - j) * DM), h1 = *(const f32x4*)(sp + (size_t)(15 - j) * DM + 4);
            const float mk = j < w ? 1.0f : 0.0f;
            S[0] += mk * h0[0]; S[1] += mk * h0[1]; S[2] += mk * h0[2]; S[3] += mk * h0[3]; S[4] += mk * h1[0]; S[5] += mk * h1[1]; S[6] += mk * h1[2]; S[7] += mk * h1[3];
        }
        const float invw = 1.0f / (float)w; float qv[8];
#pragma unroll
        for (int j = 0; j < 8; ++j) qv[j] = S[j] * invw - xv[j];
        u32x4 o; o.x = cvt_pk_bf16(qv[0], qv[1]); o.y = cvt_pk_bf16(qv[2], qv[3]); o.z = cvt_pk_bf16(qv[4], qv[5]); o.w = cvt_pk_bf16(qv[6], qv[7]);
        *(u32x4*)(Q + (size_t)(MPR + i) * DM + c8) = o;
    }
}

__device__ __forceinline__ void phase_mixpool(LAS unsigned char* lds, const Params& p) {
    const int tid = threadIdx.x, lane = tid & 63, wid = tid >> 6, G = gridDim.x, bid = blockIdx.x;
    phase_qpass(p);
    { int hprev = -1; for (int a = bid; a < 128 * 8; a += G) { const int h = a & 7; mix_unit(lds, p, a >> 3, h, h != hprev); hprev = h; } }
    bf16_t* act = (bf16_t*)(p.ws + WS_ACT);
    const float* statv = (const float*)(p.ws + WS_STATV);
    if (wid == 0) for (int r = bid; r < MSM; r += G) {
        const int row = MPR + r;
        float s, q;
        { const f32x2 v = *(const f32x2*)((const float*)(p.ws + WS_SVS) + ((size_t)r * 64 + lane) * 2); s = v.x; q = v.y; }
        s = wave_sum(s); q = wave_sum(q);
        const float mean = s * (1.0f / DM), rstd = 1.0f / sqrtf(fmaxf(q * (1.0f / DM) - mean * mean, 0.f) + EPS);
        bf16_t* rowp = act + (size_t)row * DIN;
#pragma unroll
        for (int i = 0; i < 4; ++i) {
            const int col = lane * 4 + 256 * i, h = col >> 7;
            const u32x2 gv = *(const u32x2*)(rowp + C_V + col), uu = *(const u32x2*)(rowp + C_U + col), za = *(const u32x2*)(rowp + C_ZA + col);
            const f32x4 lg = *(const f32x4*)(p.ln_g + col), lb = *(const f32x4*)(p.ln_b + col);
            const float w00 = p.w_s[(size_t)h * 128 * 128], bs = p.b_s[h * 128];
            f32x4 vn; vn[0] = (bf_lo(gv.x) - mean) * rstd * lg[0] + lb[0]; vn[1] = (bf_hi(gv.x) - mean) * rstd * lg[1] + lb[1];
            vn[2] = (bf_lo(gv.y) - mean) * rstd * lg[2] + lb[2]; vn[3] = (bf_hi(gv.y) - mean) * rstd * lg[3] + lb[3];
            *(f32x4*)(p.out + O_SCV + (size_t)r * DM + col) = vn;
            const float z0 = bf_lo(za.x), z1 = bf_hi(za.x), z2 = bf_lo(za.y), z3 = bf_hi(za.y);
            u32x2 o; o.x = cvt_pk_bf16(gelu_t(bf_lo(uu.x)) * (w00 * vn[0] + bs) * (z0 * sigm(z0)), gelu_t(bf_hi(uu.x)) * (w00 * vn[1] + bs) * (z1 * sigm(z1)));
            o.y = cvt_pk_bf16(gelu_t(bf_lo(uu.y)) * (w00 * vn[2] + bs) * (z2 * sigm(z2)), gelu_t(bf_hi(uu.y)) * (w00 * vn[3] + bs) * (z3 * sigm(z3)));
            *(u32x2*)(rowp + C_U + col) = o;
        }
    }
}

struct Row5 { f32x4 hv[4]; u32x2 tv[4]; f32x4 pv; float q; };
__device__ __forceinline__ void row5_load(const Params& p, int row, int lane, Row5& R) {
    const bf16_t* act = (const bf16_t*)(p.ws + WS_ACT);
    const float* hsrc = row < MPR ? p.x_prompt + (size_t)row * DM : p.x_sample + (size_t)(row - MPR) * DM;
    const float* psrc = row < MPR ? p.p_prompt + (size_t)row * PLE : p.p_sample + (size_t)(row - MPR) * PLE;
    R.q = row < MPR ? (lane < 16 ? ((const float*)(p.ws + WS_STATT))[(size_t)row * 16 + lane] : 0.f) : ((const float*)(p.ws + WS_STS))[(size_t)(row - MPR) * 64 + lane];
#pragma unroll
    for (int i = 0; i < 4; ++i) { const int col = lane * 4 + 256 * i; R.hv[i] = *(const f32x4*)(hsrc + col); R.tv[i] = *(const u32x2*)(act + (size_t)row * DIN + C_T + col); }
    R.pv = *(const f32x4*)(psrc + lane * 4);
}
__device__ __forceinline__ void row5_finish(const Params& p, int row, int lane, Row5& R) {
    bf16_t* arow = (bf16_t*)(p.ws + WS_ACT) + (size_t)row * DIN;
    const float rstd = 1.0f / sqrtf(wave_sum(R.q) * (1.0f / DM) + EPS);
    f32x4 h1[4]; float ss = 0.f;
#pragma unroll
    for (int i = 0; i < 4; ++i) {
        const int col = lane * 4 + 256 * i;
        const f32x4 gv = *(const f32x4*)(p.post_g + col);
        const f32x4 tv = (f32x4){bf_lo(R.tv[i].x), bf_hi(R.tv[i].x), bf_lo(R.tv[i].y), bf_hi(R.tv[i].y)};
        h1[i] = R.hv[i] + tv * rstd * gv;
        ss += (h1[i][0] * h1[i][0] + h1[i][1] * h1[i][1]) + (h1[i][2] * h1[i][2] + h1[i][3] * h1[i][3]);
        *(f32x4*)(p.out + (size_t)row * DM + col) = h1[i];
    }
    const float rstd1 = 1.0f / sqrtf(wave_sum(ss) * (1.0f / DM) + EPS);
#pragma unroll
    for (int i = 0; i < 4; ++i) {
        const int col = lane * 4 + 256 * i;
        const f32x4 gv = *(const f32x4*)(p.ple_in_g + col);
        u32x2 w; w.x = cvt_pk_bf16(h1[i][0] * rstd1 * gv[0], h1[i][1] * rstd1 * gv[1]); w.y = cvt_pk_bf16(h1[i][2] * rstd1 * gv[2], h1[i][3] * rstd1 * gv[3]);
        *(u32x2*)(arow + PLE + col) = w;
    }
    { u32x2 w; w.x = cvt_pk_bf16(R.pv[0], R.pv[1]); w.y = cvt_pk_bf16(R.pv[2], R.pv[3]); *(u32x2*)(arow + lane * 4) = w; }
}
__device__ __forceinline__ void phase_rows5(const Params& p, int first_row) {
    const int tid = threadIdx.x, lane = tid & 63, wid = tid >> 6, G = gridDim.x, bid = blockIdx.x, step = G * 8;
    int row = first_row + bid * 8 + wid;
    for (; row + step < MREAL; row += 2 * step) {
        Row5 a, b; row5_load(p, row, lane, a); row5_load(p, row + step, lane, b);
        row5_finish(p, row, lane, a); row5_finish(p, row + step, lane, b);
    }
    if (row < MREAL) { Row5 a; row5_load(p, row, lane, a); row5_finish(p, row, lane, a); }
}
struct Row7 { f32x4 hv[4]; u32x2 gv[4]; float q; };
__device__ __forceinline__ void row7_load(const Params& p, int row, int lane, Row7& R) {
    const bf16_t* act = (const bf16_t*)(p.ws + WS_ACT);
    R.q = row < MPR ? (lane < 16 ? ((const float*)(p.ws + WS_STATG))[(size_t)row * 16 + lane] : 0.f) : ((const float*)(p.ws + WS_SGS))[(size_t)(row - MPR) * 64 + lane];
#pragma unroll
    for (int i = 0; i < 4; ++i) { const int col = lane * 4 + 256 * i; R.hv[i] = *(const f32x4*)(p.out + (size_t)row * DM + col); R.gv[i] = *(const u32x2*)(act + (size_t)row * DIN + C_GE + col); }
}
__device__ __forceinline__ void row7_finish(const Params& p, int row, int lane, Row7& R) {
    const float rstd = 1.0f / sqrtf(wave_sum(R.q) * (1.0f / DM) + EPS);
#pragma unroll
    for (int i = 0; i < 4; ++i) {
        const int col = lane * 4 + 256 * i;
        const f32x4 g = *(const f32x4*)(p.ple_out_g + col);
        const f32x4 ge = (f32x4){bf_lo(R.gv[i].x), bf_hi(R.gv[i].x), bf_lo(R.gv[i].y), bf_hi(R.gv[i].y)};
        *(f32x4*)(p.out + (size_t)row * DM + col) = R.hv[i] + ge * rstd * g;
    }
}
__device__ __forceinline__ void phase_rows7(const Params& p, int first_row) {
    const int tid = threadIdx.x, lane = tid & 63, wid = tid >> 6, G = gridDim.x, bid = blockIdx.x, step = G * 8;
    int row = first_row + bid * 8 + wid;
    for (; row + step < MREAL; row += 2 * step) {
        Row7 a, b; row7_load(p, row, lane, a); row7_load(p, row + step, lane, b);
        row7_finish(p, row, lane, a); row7_finish(p, row + step, lane, b);
    }
    if (row < MREAL) { Row7 a; row7_load(p, row, lane, a); row7_finish(p, row, lane, a); }
}

__global__ void __launch_bounds__(NTHR, 2) fwd_megakernel(Params p) {
    extern __shared__ __attribute__((aligned(16))) unsigned char lds_raw[];
    LAS unsigned char* lds = (LAS unsigned char*)lds_raw;
    cg::grid_group grid = cg::this_grid();
    const int G = gridDim.x, bid = blockIdx.x;
    bf16_t* act = (bf16_t*)(p.ws + WS_ACT);
    volatile LAS unsigned* xb_st = (volatile LAS unsigned*)(lds + 131072);
    if (threadIdx.x < 4) xb_st[threadIdx.x] = 0u;
    __syncthreads();
    const XcdBarrier xbar = xcd_barrier_post((unsigned*)(p.ws + WS_BAR), xb_st);
#define SEAM() xcd_barrier(xbar)

    phase_prep(lds, p);
    SEAM();
    {
        pg8::Gemm g{(const bf16_t*)((unsigned char*)p.out + DO_XN), (const bf16_t*)((unsigned char*)p.out + DO_WIN), DM, DM, DM, 0};
        pg8::StaticOrder S; S.init(MPR / 256, DIN / 256, G, bid);
        EpiAct E{act, (float*)(p.ws + WS_STATV), p.out};
        pg8::gemm_phase<EpiAct, pg8::StaticOrder, K_ALIGN, K_SP2>(lds, g, S, E);
        small_gemm1<2>(p, g.A, g.lda, g.Bt, g.ldb, g.K, DIN / 32);
    }
    SEAM();
    phase_mixpool(lds, p);
    SEAM();
    {
        pg8::Gemm g{(const bf16_t*)((unsigned char*)p.out + DO_XN), (const bf16_t*)(p.ws + WS_WPOOL), DM, 256, 256, 256 * 2};
        pg8::StaticOrder S; S.init(MPR / 256, 4, G, bid);
        EpiPool E{act, p.pool_scale};
        pg8::gemm_phase<EpiPool, pg8::StaticOrder, K_ALIGN, K_SP2, PreSmall2<2>>(lds, g, S, E, PreSmall2<2>{lds, p, g.A, g.lda, g.Bt, g.ldb});
    }
    SEAM();
    {
        pg8::Gemm g{act + C_U, (const bf16_t*)(p.ws + WS_WCAT), DIN, 2048, 2048, 0};
        pg8::StaticOrder S; S.init(MPR / 256, 4, G, bid);
        EpiMerge E{act};
        pg8::gemm_phase<EpiMerge, pg8::StaticOrder, K_ALIGN, K_SP2, PreSmall2<3>>(lds, g, S, E, PreSmall2<3>{lds, p, g.A, g.lda, g.Bt, g.ldb});
    }
    SEAM();
    const bool fusedn = (G == 256);
    {
        pg8::Gemm g{act + C_M, (const bf16_t*)(p.ws + WS_WOUT), DIN, 1024, 1024, 0};
        pg8::StaticOrder S; S.init(MPR / 256, 4, G, bid);
        if (fusedn) {
            for (int row = bid * 8 + (threadIdx.x >> 6); row < MPR; row += G * 8) {
                const int lane = threadIdx.x & 63; const f32x4 pv = *(const f32x4*)(p.p_prompt + (size_t)row * PLE + lane * 4);
                u32x2 w; w.x = cvt_pk_bf16(pv[0], pv[1]); w.y = cvt_pk_bf16(pv[2], pv[3]); *(u32x2*)(act + (size_t)row * DIN + lane * 4) = w;
            }
            float* xb = (float*)(p.ws + WS_XBUF); unsigned* xc = (unsigned*)(p.ws + WS_XCNT);
            EpiOutF E{act, p.x_prompt, (float*)(p.ws + WS_RSTD1), p.post_g, p.ple_in_g, RowX{xb, xc}, RowX{xb + 64 * 256 * 4, xc + 64 * 64}};
            pg8::gemm_phase<EpiOutF, pg8::StaticOrder, false, K_SP2, PreSmall2<4>>(lds, g, S, E, PreSmall2<4>{lds, p, g.A, g.lda, g.Bt, g.ldb});
        } else {
            EpiOut E{act, (float*)(p.ws + WS_STATT)};
            pg8::gemm_phase<EpiOut, pg8::StaticOrder, K_ALIGN, K_SP2, PreSmall2<4>>(lds, g, S, E, PreSmall2<4>{lds, p, g.A, g.lda, g.Bt, g.ldb});
        }
    }
    SEAM();
    if (fusedn) { if ((threadIdx.x >> 6) == 0 && bid < MSM) { Row5 a; row5_load(p, MPR + bid, threadIdx.x & 63, a); row5_finish(p, MPR + bid, threadIdx.x & 63, a); } }
    else phase_rows5(p, 0);
    SEAM();
    {
        pg8::Gemm g{act, (const bf16_t*)(p.ws + WS_W6), DIN, 1280, 1280, 0};
        pg8::StaticOrder S; S.init(MPR / 256, 4, G, bid);
        if (fusedn) {
            EpiGateF E{act, p.out, p.ple_out_g, p.ple_in_g, (const float*)(p.ws + WS_RSTD1), RowX{(float*)(p.ws + WS_XBUF) + 2 * 64 * 256 * 4, (unsigned*)(p.ws + WS_XCNT) + 2 * 64 * 64}};
            pg8::gemm_phase<EpiGateF, pg8::StaticOrder, false, K_SP2, PreSmall2<6>>(lds, g, S, E, PreSmall2<6>{lds, p, g.A, g.lda, g.Bt, g.ldb});
        } else {
            EpiGate E{act, (float*)(p.ws + WS_STATG)};
            pg8::gemm_phase<EpiGate, pg8::StaticOrder, K_ALIGN, K_SP2, PreSmall2<6>>(lds, g, S, E, PreSmall2<6>{lds, p, g.A, g.lda, g.Bt, g.ldb});
        }
    }
    SEAM();
    if (fusedn) { if ((threadIdx.x >> 6) == 0 && bid < MSM) { Row7 a; row7_load(p, MPR + bid, threadIdx.x & 63, a); row7_finish(p, MPR + bid, threadIdx.x & 63, a); } }
    else phase_rows7(p, 0);
    if (gridDim.y > 1) grid.sync();
}

extern "C" void kernel_launch(void* const* d_in, const int* in_sizes, int n_in, void* d_out, int out_size, void* d_ws, size_t ws_size, hipStream_t stream) {
    constexpr size_t kDynLds = LDS_BYTES;
    static int grid_blocks = 0;
    if (!grid_blocks) {
        if (ws_size < WS_END) { fprintf(stderr, "kernel_launch: workspace too small: %zu < %zu\n", ws_size, (size_t)WS_END); grid_blocks = -1; return; }
        int dev = 0, cus = 0, per_cu = 0;
        (void)hipGetDevice(&dev);
        (void)hipDeviceGetAttribute(&cus, hipDeviceAttributeMultiprocessorCount, dev);
        (void)hipFuncSetAttribute((const void*)fwd_megakernel, hipFuncAttributeMaxDynamicSharedMemorySize, (int)kDynLds);
        (void)hipOccupancyMaxActiveBlocksPerMultiprocessor(&per_cu, (const void*)fwd_megakernel, NTHR, kDynLds);
        if (per_cu < 1) { fprintf(stderr, "kernel_launch: occupancy query says %d blocks per CU\n", per_cu); per_cu = 1; }
        grid_blocks = cus;
    }
    if (grid_blocks < 0) return;
    if (hipMemsetAsync((unsigned char*)d_ws + WS_BAR, 0, ZERO_BYTES, stream) != hipSuccess) { fprintf(stderr, "kernel_launch: memset of the barrier words failed\n"); return; }
    Params p{};
    const float** f = (const float**)&p;
    for (int i = 0; i < 21; ++i) f[i] = (const float*)d_in[i];
    p.out = (float*)d_out; p.ws = (unsigned char*)d_ws;
    void* args[] = {&p};
    hipError_t e = hipLaunchCooperativeKernel((const void*)fwd_megakernel, dim3(grid_blocks), dim3(NTHR), args, kDynLds, stream);
    if (e != hipSuccess) fprintf(stderr, "cooperative launch failed: %s (grid %d)\n", hipGetErrorString(e), grid_blocks);
}
```

```cpp
#ifndef K_SP2
#define K_SP2 true
#endif
#ifndef K_ALIGN
#define K_ALIGN true
#endif
#include <hip/hip_runtime.h>
#include <hip/hip_cooperative_groups.h>
#include <cstdio>
namespace cg = cooperative_groups;

#define LAS __attribute__((address_space(3)))
typedef unsigned short bf16_t;
typedef short bf16x8 __attribute__((ext_vector_type(8)));
typedef float f32x4 __attribute__((ext_vector_type(4)));
typedef float f32x2 __attribute__((ext_vector_type(2)));
typedef unsigned u32x4 __attribute__((ext_vector_type(4)));
typedef unsigned u32x2 __attribute__((ext_vector_type(2)));

constexpr int DM = 1024, MPR = 16384, MSM = 128, MREAL = MPR + MSM, MT = 16640, DIN = 7168, PLE = 256, SEQ = 2048;
constexpr int NTHR = 512;
constexpr int XCD_BAR_WORDS_C = 3456;
constexpr int LDS_BYTES = 131072 + 64 + 8192;
constexpr float EPS = 1e-6f;
constexpr int C_U = 0, C_ZB = 1024, C_V = 2048, C_ZA = 3072, C_XB = 4096, C_GA = 5120, C_GB = 6144;
constexpr int C_M = 2048;
constexpr int C_E = 2048;
constexpr int C_T = 3072;
constexpr int C_GE = 5120;
constexpr int LDF = DIN / 2;
constexpr int CF_T = 1536;
constexpr int CF_GE = 2560;
constexpr size_t O_YP = 0, O_YS = (size_t)MPR * DM, O_PCV = O_YS + (size_t)MSM * DM, O_PP = O_PCV + (size_t)8 * 128 * DM,
                 O_SCV = O_PP + (size_t)8 * 15 * DM, O_SP = O_SCV + (size_t)MSM * DM;
constexpr size_t DO_XN = 0, DO_WIN = (size_t)MT * DM * 2;
constexpr size_t WS_ACT = 0;
constexpr size_t WS_WCAT = WS_ACT + (size_t)MT * DIN * 2;
constexpr size_t WS_WOUT = WS_WCAT + (size_t)1024 * 2048 * 2;
constexpr size_t WS_W6 = WS_WOUT + (size_t)1024 * 1024 * 2;
constexpr size_t WS_WPOOL = WS_W6 + (size_t)1024 * 1280 * 2;
constexpr size_t WS_WS = WS_WPOOL + (size_t)4 * 256 * 256 * 2;
constexpr size_t WS_STATV = WS_WS + (size_t)8 * 128 * 128 * 2;
constexpr size_t WS_STATT = WS_STATV + (size_t)MT * 16 * 2 * 4;
constexpr size_t WS_STATG = WS_STATT + (size_t)MT * 16 * 4;
constexpr size_t WS_BAR = WS_STATG + (size_t)MT * 16 * 4;
constexpr size_t WS_XCNT = WS_BAR + (size_t)XCD_BAR_WORDS_C * 4;
constexpr size_t WS_TICK = WS_XCNT + (size_t)3 * 64 * 64 * 4;
constexpr size_t WS_XBUF = WS_TICK + (size_t)2 * 4 * 64 * 4;
constexpr size_t ZERO_BYTES = WS_XBUF - WS_BAR;
constexpr size_t WS_SVS = WS_XBUF + (size_t)3 * 64 * 256 * 4 * 4;
constexpr size_t WS_STS = WS_SVS + (size_t)MSM * 64 * 2 * 4;
constexpr size_t WS_SGS = WS_STS + (size_t)MSM * 64 * 4;
constexpr size_t WS_RSTD1 = WS_SGS + (size_t)MSM * 64 * 4;
constexpr size_t WS_END = WS_RSTD1 + (size_t)MPR * 4;

struct Params {
    const float* x_prompt; const float* x_sample; const float* state_pool; const float* p_prompt; const float* p_sample;
    const float* pre_g; const float* w_in; const float* ln_g; const float* ln_b; const float* w_s; const float* b_s;
    const float* w_pool; const float* pool_scale; const float* w_pa; const float* w_pb; const float* w_out; const float* post_g;
    const float* w_ple; const float* w_pg; const float* ple_in_g; const float* ple_out_g;
    float* out; unsigned char* ws;
};

typedef __bf16 bf16x2_t __attribute__((ext_vector_type(2)));
__device__ __forceinline__ unsigned cvt_pk_bf16(float lo, float hi) { const bf16x2_t r = __builtin_convertvector((f32x2){lo, hi}, bf16x2_t); return __builtin_bit_cast(unsigned, r); }
__device__ __forceinline__ float bf_lo(unsigned w) { return __uint_as_float(w << 16); }
__device__ __forceinline__ float bf_hi(unsigned w) { return __uint_as_float(w & 0xffff0000u); }
__device__ __forceinline__ float sigm(float x) { return __builtin_amdgcn_rcpf(1.0f + __builtin_amdgcn_exp2f(-1.44269504089f * x)); }
__device__ __forceinline__ float gelu_t(float x) { return x * __builtin_amdgcn_rcpf(1.0f + __builtin_amdgcn_exp2f(x * (-2.30220819f - 0.10294324f * x * x))); }
__device__ __forceinline__ float wave_sum(float v) {
#pragma unroll
    for (int o = 32; o >= 1; o >>= 1) v += __shfl_xor(v, o);
    return v;
}


#define XB_TMO      128
#define XB_XCNT(j)  (256  + 64 * (j))
#define XB_XSUB(j)  (1280 + 64 * (j))
#define XB_XGEN(j)  (2304 + 64 * (j))
#define XB_TOP      3328
#define XB_TOPGEN   3392
#define XCD_BAR_WORDS 3456
#define XB_SPIN_CAP (1u << 18)
__device__ __forceinline__ unsigned xb_ld(unsigned* p)              { return __hip_atomic_load(p, __ATOMIC_RELAXED, __HIP_MEMORY_SCOPE_AGENT); }
__device__ __forceinline__ unsigned xb_add(unsigned* p, unsigned v) { return __hip_atomic_fetch_add(p, v, __ATOMIC_RELAXED, __HIP_MEMORY_SCOPE_AGENT); }
__device__ __forceinline__ unsigned xb_xcc_id() { return (unsigned)__builtin_amdgcn_s_getreg((3 << 11) | 20) & 0xFu; }
#define XB_SPIN(cond, bar) do { unsigned _sp = 0; while (cond) { __builtin_amdgcn_s_sleep(1); \
    if ((++_sp & 255u) == 0u) { if (xb_ld(&(bar)[XB_TMO])) break; if (_sp > XB_SPIN_CAP) { atomicAdd(&(bar)[XB_TMO], 1u); break; } } } } while (0)
struct XcdBarrier { unsigned* bar; unsigned x; volatile LAS unsigned* st; };
__device__ __forceinline__ XcdBarrier xcd_barrier_post(unsigned* bar, volatile LAS unsigned* st) {
    XcdBarrier b; b.bar = bar; b.x = xb_xcc_id(); b.st = st;
    if (threadIdx.x == 0) (void)xb_add(&bar[XB_XCNT(b.x)], 1u);
    return b;
}
__device__ __forceinline__ void xcd_barrier_complete(unsigned* bar, unsigned x, unsigned& nloc, unsigned& nx) {
    const unsigned G = gridDim.x * gridDim.y * gridDim.z;
    unsigned sum, cnt, mine, sp = 0u;
    for (;;) {
        sum = 0u; cnt = 0u; mine = 0u;
#pragma unroll
        for (unsigned j = 0; j < 16; ++j) { const unsigned c = xb_ld(&bar[XB_XCNT(j)]); sum += c; cnt += (c > 0u) ? 1u : 0u; mine = (j == x) ? c : mine; }
        if (sum == G) break;
        __builtin_amdgcn_s_sleep(1);
        if ((++sp & 255u) == 0u) { if (xb_ld(&bar[XB_TMO])) break; if (sp > XB_SPIN_CAP) { atomicAdd(&bar[XB_TMO], 1u); break; } }
    }
    nloc = mine > 0u ? mine : 1u; nx = cnt > 0u ? cnt : 1u;
}
__device__ __forceinline__ void xcd_barrier(const XcdBarrier& b) {
    asm volatile("s_waitcnt vmcnt(0)" ::: "memory");
    __syncthreads();
    if (threadIdx.x == 0) {
        unsigned* bar = b.bar;
        __builtin_amdgcn_s_waitcnt(0);
        unsigned nloc = b.st[0], nx = b.st[1];
        if (nloc == 0u) { xcd_barrier_complete(bar, b.x, nloc, nx); b.st[0] = nloc; b.st[1] = nx; }
        const unsigned old = xb_add(&bar[XB_XSUB(b.x)], 1u);
        const unsigned gen = old / nloc;
        if (old + 1u == (gen + 1u) * nloc) {
            __builtin_amdgcn_fence(__ATOMIC_RELEASE, "agent");
            asm volatile("s_waitcnt vmcnt(0)" ::: "memory");
            const unsigned og = xb_add(&bar[XB_TOP], 1u);
            const unsigned tg = og / nx;
            if (og + 1u == (tg + 1u) * nx) xb_add(&bar[XB_TOPGEN], 1u);
            else XB_SPIN(xb_ld(&bar[XB_TOPGEN]) == tg, bar);
            __builtin_amdgcn_fence(__ATOMIC_ACQUIRE, "agent");
            xb_add(&bar[XB_XGEN(b.x)], 1u);
            asm volatile("s_waitcnt vmcnt(0)" ::: "memory");
        } else {
            XB_SPIN(xb_ld(&bar[XB_XGEN(b.x)]) == gen, bar);
            __builtin_amdgcn_fence(__ATOMIC_ACQUIRE, "agent");
            asm volatile("s_waitcnt vmcnt(0)" ::: "memory");
        }
    }
    __syncthreads();
}

namespace pg8 {
constexpr int BM = 256, BK = 64, HALF = 128, HTB = HALF * BK * 2, STAGE_BYTES = 8 * HTB, NXCD = 8, WGM = 8;
__host__ __device__ __forceinline__ int lds_byte(int r, int c) { const int st = (r >> 4) * 2 + (c >> 5), rr = r & 15, cc = c & 31, ob = rr * 64 + cc * 2; return st * 1024 + (ob ^ (((ob >> 9) & 1) << 5)); }
__host__ __device__ __forceinline__ void stage_rc(int b, int& R, int& C) { const int st = b / 1024, sb = b % 1024, swz = sb ^ (((sb >> 9) & 1) << 5); R = (st >> 1) * 16 + swz / 64; C = (st & 1) * 32 + (swz % 64) / 2; }
__host__ __device__ __forceinline__ int perm32(int rho) { const int n = rho >> 4, i = rho & 15; return 8 * (i >> 2) + 4 * n + (i & 3); }

struct Unit { int pm, pn; };
struct Gemm { const bf16_t* A; const bf16_t* Bt; int lda, ldb, K, a_pn_off; };

struct StaticOrder {
    int nM, nN, nwg, G, c;
    __device__ void init(int nM_, int nN_, int G_, int c_) { nM = nM_; nN = nN_; nwg = nM * nN; G = G_; c = c_; }
    __device__ bool next(int i, Unit& u) const {
        const long L = (long)i * G + c; if (L >= nwg) return false;
        int wgid = (int)L; { const int q = nwg / NXCD, r = nwg % NXCD, xcd = wgid % NXCD, off = wgid / NXCD; wgid = (xcd < r ? xcd * (q + 1) : r * (q + 1) + (xcd - r) * q) + off; }
        const int nig = WGM * nN, gid = wgid / nig, fm = gid * WGM, gsz = (nM - fm) < WGM ? (nM - fm) : WGM;
        u.pm = fm + ((wgid % nig) % gsz); u.pn = (wgid % nig) / gsz; return true;
    }
};

struct NoPre { __device__ __forceinline__ void operator()() const {} };
template <class Epi, class Sched, bool ALIGN_EPI = false, bool SP2 = false, class Pre = NoPre>
__device__ __forceinline__ void gemm_phase(LAS unsigned char* lds, const Gemm g, const Sched& S, const Epi& E, const Pre& pre = Pre()) {
    const int tid = threadIdx.x, wid = __builtin_amdgcn_readfirstlane(tid >> 6), lane = tid & 63, wr = wid >> 2, wc = wid & 3, fr = lane & 15, fq = lane >> 4;
    const int K = g.K, nt = K / BK;
    unsigned voffA[2], voffB[2];
#pragma unroll
    for (int i = 0; i < 2; ++i) { int R, C; stage_rc(tid * 16 + i * 8192, R, C); const int Rb = Epi::PERM ? ((R & ~31) + perm32(R & 31)) : R;
        voffA[i] = (unsigned)(R * g.lda + C) * 2u; voffB[i] = (unsigned)(Rb * g.ldb + C) * 2u; }
    const size_t kstep = (size_t)(BK * 2);
    const size_t hstepA = (size_t)HALF * g.lda * 2, hstepB = (size_t)HALF * g.ldb * 2;
    const size_t tstepA = 2 * hstepA, tstepB = 2 * hstepB;
    const unsigned ldsw = (unsigned)wid * 1024u;
    const int aoff = lds_byte(wr * 64 + fr, fq * 8), boff = lds_byte(wc * 32 + fr, fq * 8);
#define PG8_SA(b, h) (((b) * 2 + (h)) * HTB)
#define PG8_SB(b, h) ((4 + (b) * 2 + (h)) * HTB)
#define PG8_STAGE(bufoff, gbase, voff) do { _Pragma("unroll") for (int _i = 0; _i < 2; ++_i) \
        __builtin_amdgcn_global_load_lds((const unsigned*)((const char*)(gbase) + (voff)[_i]), (LAS unsigned*)(lds + (bufoff) + ldsw + _i * 8192), 16, 0, 0); } while (0)
#define PG8_LDA(dst, b, h) do { _Pragma("unroll") for (int m = 0; m < 4; ++m) _Pragma("unroll") for (int k = 0; k < 2; ++k) dst[m][k] = *(const LAS bf16x8*)(lds + PG8_SA(b, h) + aoff + m * 2048 + k * 1024); } while (0)
#define PG8_LDB(dst, b, h) do { _Pragma("unroll") for (int n = 0; n < 2; ++n) _Pragma("unroll") for (int k = 0; k < 2; ++k) dst[n][k] = *(const LAS bf16x8*)(lds + PG8_SB(b, h) + boff + n * 2048 + k * 1024); } while (0)
#define PG8_MMA(ai, bj, At, Bt) do { __builtin_amdgcn_s_setprio(1); _Pragma("unroll") for (int m = 0; m < 4; ++m) _Pragma("unroll") for (int n = 0; n < 2; ++n) _Pragma("unroll") for (int k = 0; k < 2; ++k) \
        acc[ai][bj][m][n] = __builtin_amdgcn_mfma_f32_16x16x32_bf16(Bt[n][k], At[m][k], acc[ai][bj][m][n], 0, 0, 0); __builtin_amdgcn_s_setprio(0); } while (0)
#define PG8_WAIT_V(n) asm volatile("s_waitcnt vmcnt(" #n ")" ::: "memory")
#define PG8_WAIT_L(n) asm volatile("s_waitcnt lgkmcnt(" #n ")" ::: "memory")
#define PG8_BAR __builtin_amdgcn_s_barrier()
#define PG8_SCHED __builtin_amdgcn_sched_barrier(0)
    Unit cur, nxt; int ui = 0;
    if (!S.next(0, cur)) { pre(); return; }
    f32x4 acc[2][2][4][2];
#pragma unroll
    for (int a = 0; a < 2; ++a)
#pragma unroll
        for (int b = 0; b < 2; ++b)
#pragma unroll
            for (int m = 0; m < 4; ++m)
#pragma unroll
                for (int n = 0; n < 2; ++n) acc[a][b][m][n] = (f32x4){0.f, 0.f, 0.f, 0.f};
    bf16x8 At[4][2], B0[2][2], B1[2][2];
    const char* cA = (const char*)g.A + (size_t)cur.pm * tstepA + (size_t)cur.pn * g.a_pn_off; const char* cB = (const char*)g.Bt + (size_t)cur.pn * tstepB;
    if constexpr (SP2) {
        PG8_STAGE(PG8_SB(0, 0), cB, voffB); PG8_STAGE(PG8_SB(0, 1), cB + hstepB, voffB); PG8_STAGE(PG8_SA(0, 0), cA, voffA); PG8_STAGE(PG8_SA(0, 1), cA + hstepA, voffA);
        pre();
        if (wr == 1) PG8_BAR;
        PG8_WAIT_V(2); PG8_BAR;
        PG8_STAGE(PG8_SB(1, 0), cB + kstep, voffB); PG8_STAGE(PG8_SA(1, 0), cA + kstep, voffA); PG8_STAGE(PG8_SB(1, 1), cB + hstepB + kstep, voffB);
        PG8_WAIT_V(6); PG8_BAR;
    } else {
        PG8_STAGE(PG8_SB(0, 0), cB, voffB); PG8_STAGE(PG8_SA(0, 0), cA, voffA); PG8_STAGE(PG8_SB(0, 1), cB + hstepB, voffB); PG8_STAGE(PG8_SA(0, 1), cA + hstepA, voffA);
        pre();
        if (wr == 1) PG8_BAR;
        PG8_WAIT_V(4); PG8_BAR;
        PG8_STAGE(PG8_SB(1, 0), cB + kstep, voffB); PG8_STAGE(PG8_SA(1, 0), cA + kstep, voffA); PG8_STAGE(PG8_SB(1, 1), cB + hstepB + kstep, voffB);
        PG8_WAIT_V(6); PG8_BAR;
    }
    for (;;) {
        const bool has_next = S.next(ui + 1, nxt);
        const char* nA = has_next ? (const char*)g.A + (size_t)nxt.pm * tstepA + (size_t)nxt.pn * g.a_pn_off : cA; const char* nB = has_next ? (const char*)g.Bt + (size_t)nxt.pn * tstepB : cB;
        int t = 0;
#pragma unroll 1
        for (int seg = 0; seg < (Epi::MID_T >= 0 ? 2 : 1); ++seg) {
        const int tend = (Epi::MID_T >= 0 && seg == 0) ? Epi::MID_T : nt;
#pragma unroll 1
        for (; t < tend; t += 2) {
            const bool last = (t == nt - 2);
            const char* a1 = cA + (size_t)(t + 1) * kstep;
            const char* a2 = last ? nA : cA + (size_t)(t + 2) * kstep; const char* b2 = last ? nB : cB + (size_t)(t + 2) * kstep;
            const char* a3 = a2 + kstep; const char* b3 = b2 + kstep;
            if constexpr (SP2) {
            PG8_LDB(B0, 0, 0); PG8_LDB(B1, 0, 1); PG8_SCHED; PG8_LDA(At, 0, 0); PG8_STAGE(PG8_SA(1, 1), a1 + hstepA, voffA);
            PG8_WAIT_V(8); PG8_WAIT_L(0); PG8_BAR; PG8_MMA(0, 0, At, B0); PG8_MMA(0, 1, At, B1); PG8_BAR; PG8_SCHED;
            PG8_LDA(At, 0, 1); PG8_STAGE(PG8_SB(0, 0), b2, voffB); PG8_STAGE(PG8_SB(0, 1), b2 + hstepB, voffB); PG8_STAGE(PG8_SA(0, 0), a2, voffA);
            PG8_WAIT_V(8); PG8_WAIT_L(0); PG8_BAR; PG8_MMA(1, 0, At, B0); PG8_MMA(1, 1, At, B1); PG8_BAR; PG8_SCHED;
            PG8_LDB(B0, 1, 0); PG8_LDB(B1, 1, 1); PG8_SCHED; PG8_LDA(At, 1, 0); PG8_STAGE(PG8_SA(0, 1), a2 + hstepA, voffA);
            PG8_WAIT_V(8); PG8_WAIT_L(0); PG8_BAR; PG8_MMA(0, 0, At, B0); PG8_MMA(0, 1, At, B1); PG8_BAR; PG8_SCHED;
            PG8_LDA(At, 1, 1); PG8_STAGE(PG8_SB(1, 0), b3, voffB); PG8_STAGE(PG8_SB(1, 1), b3 + hstepB, voffB); PG8_STAGE(PG8_SA(1, 0), a3, voffA);
            PG8_WAIT_V(8); PG8_WAIT_L(0); PG8_BAR; PG8_MMA(1, 0, At, B0); PG8_MMA(1, 1, At, B1); PG8_BAR; PG8_SCHED;
            } else {
            PG8_LDB(B0, 0, 0); PG8_SCHED; PG8_LDA(At, 0, 0); PG8_STAGE(PG8_SA(1, 1), a1 + hstepA, voffA);
            PG8_WAIT_L(8); PG8_BAR; PG8_WAIT_L(0); PG8_MMA(0, 0, At, B0); PG8_BAR; PG8_SCHED;
            PG8_LDB(B1, 0, 1); PG8_STAGE(PG8_SB(0, 0), b2, voffB);
            PG8_BAR; PG8_WAIT_L(0); PG8_MMA(0, 1, At, B1); PG8_BAR;
            PG8_LDA(At, 0, 1); PG8_STAGE(PG8_SA(0, 0), a2, voffA);
            PG8_BAR; PG8_WAIT_L(0); PG8_MMA(1, 0, At, B0); PG8_BAR; PG8_SCHED;
            PG8_STAGE(PG8_SB(0, 1), b2 + hstepB, voffB);
            PG8_WAIT_V(6); PG8_BAR; PG8_MMA(1, 1, At, B1); PG8_BAR;
            PG8_LDB(B0, 1, 0); PG8_SCHED; PG8_LDA(At, 1, 0); PG8_STAGE(PG8_SA(0, 1), a2 + hstepA, voffA);
            PG8_WAIT_L(8); PG8_BAR; PG8_WAIT_L(0); PG8_MMA(0, 0, At, B0); PG8_BAR; PG8_SCHED;
            PG8_LDB(B1, 1, 1); PG8_STAGE(PG8_SB(1, 0), b3, voffB);
            PG8_BAR; PG8_WAIT_L(0); PG8_MMA(0, 1, At, B1); PG8_BAR;
            PG8_LDA(At, 1, 1); PG8_STAGE(PG8_SA(1, 0), a3, voffA);
            PG8_BAR; PG8_WAIT_L(0); PG8_MMA(1, 0, At, B0); PG8_BAR; PG8_SCHED;
            PG8_STAGE(PG8_SB(1, 1), b3 + hstepB, voffB);
            PG8_WAIT_V(6); PG8_BAR; PG8_MMA(1, 1, At, B1); PG8_BAR;
            }
        }
        if (Epi::MID_T >= 0 && seg == 0) {
            if (wr == 0) PG8_BAR;
            E.mid(acc, cur, wr, wc, fr, fq);
            if (wr == 1) PG8_BAR;
        }
        }
        if constexpr (ALIGN_EPI) { if (wr == 0) PG8_BAR; }
        if constexpr (!Epi::AFTER_DRAIN) E(acc, cur, wr, wc, fr, fq);
        if (!has_next) break;
#pragma unroll
        for (int a = 0; a < 2; ++a)
#pragma unroll
            for (int b = 0; b < 2; ++b)
#pragma unroll
                for (int m = 0; m < 4; ++m)
#pragma unroll
                    for (int n = 0; n < 2; ++n) acc[a][b][m][n] = (f32x4){0.f, 0.f, 0.f, 0.f};
        cur = nxt; cA = nA; cB = nB; ++ui;
        if constexpr (ALIGN_EPI) { if (wr == 1) PG8_BAR; }
    }
    PG8_WAIT_V(0);
    if constexpr (!ALIGN_EPI) { if (wr == 0) PG8_BAR; }
    PG8_BAR;
    if constexpr (Epi::AFTER_DRAIN) E.fused(acc, cur, wr, wc, fr, fq, lds, wid, lane);
#undef PG8_SA
#undef PG8_SB
#undef PG8_STAGE
#undef PG8_LDA
#undef PG8_LDB
#undef PG8_MMA
#undef PG8_WAIT_V
#undef PG8_WAIT_L
#undef PG8_BAR
#undef PG8_SCHED
}
}
using pg8::Unit;
typedef f32x4 Acc[2][2][4][2];

struct EpiAct {
    static constexpr bool PERM = true, AFTER_DRAIN = false; static constexpr int MID_T = -1;
    bf16_t* act; float* statv; float* out;
    __device__ __forceinline__ void mid(Acc&, const Unit&, int, int, int, int) const {}
    template <int KIND> __device__ __forceinline__ void run(Acc& acc, const Unit& u, int wr, int wc, int fr, int fq) const {
        const int blk = u.pn >> 2;
        int row0 = u.pm * 256 + wr * 64 + fr, col0 = u.pn * 256 + wc * 32 + 8 * fq; asm volatile("" : "+v"(row0), "+v"(col0));
#pragma unroll
        for (int ai = 0; ai < 2; ++ai)
#pragma unroll
            for (int m = 0; m < 4; ++m) {
                const int row = row0 + ai * 128 + m * 16;
                bf16_t* rowp = act + (size_t)row * DIN + col0;
                float s = 0.f, q = 0.f;
#pragma unroll
                for (int bj = 0; bj < 2; ++bj) {
                    f32x4 v0 = acc[ai][bj][m][0], v1 = acc[ai][bj][m][1];
#pragma unroll
                    for (int j = 0; j < 4; ++j) {
                        if (KIND == 0) { v0[j] = gelu_t(v0[j]); v1[j] = gelu_t(v1[j]); }
                        if (KIND == 1) { v0[j] = v0[j] * sigm(v0[j]); v1[j] = v1[j] * sigm(v1[j]); }
                        if (KIND == 3) { v0[j] = sigm(v0[j]); v1[j] = sigm(v1[j]); }
                    }
                    if (KIND == 0) {
#pragma unroll
                        for (int j = 0; j < 4; ++j) { s += v0[j] + v1[j]; q += v0[j] * v0[j] + v1[j] * v1[j]; }
                    }
                    u32x4 w; w.x = cvt_pk_bf16(v0[0], v0[1]); w.y = cvt_pk_bf16(v0[2], v0[3]); w.z = cvt_pk_bf16(v1[0], v1[1]); w.w = cvt_pk_bf16(v1[2], v1[3]);
                    *(u32x4*)(rowp + bj * 128) = w;
                    if (KIND == 2 && blk == 4) {
                        const int cb = (u.pn & 3) * 256 + wc * 32 + 8 * fq + bj * 128;
                        float* dst = nullptr;
                        if (row < MPR) { const int pos = row & (SEQ - 1); if (pos >= SEQ - 15) dst = out + O_PP + ((size_t)(row >> 11) * 15 + (pos - (SEQ - 15))) * DM + cb; }
                        else if (row < MREAL) dst = out + O_SP + ((size_t)(row - MPR) * 15 + 14) * DM + cb;
                        if (dst) { *(f32x4*)dst = v0; *(f32x4*)(dst + 4) = v1; }
                    }
                }
                if (KIND == 0 && blk == 2) {
                    s += __shfl_xor(s, 16); s += __shfl_xor(s, 32); q += __shfl_xor(q, 16); q += __shfl_xor(q, 32);
                    if (fq == 0) *(f32x2*)(statv + ((size_t)row * 16 + (u.pn & 3) * 4 + wc) * 2) = (f32x2){s, q};
                }
            }
    }
    __device__ __forceinline__ void operator()(Acc& acc, const Unit& u, int wr, int wc, int fr, int fq) const {
        const int blk = u.pn >> 2;
        if (blk == 2) run<0>(acc, u, wr, wc, fr, fq);
        else if (blk == 1) run<1>(acc, u, wr, wc, fr, fq);
        else if (blk == 0 || blk == 3 || blk == 4) run<2>(acc, u, wr, wc, fr, fq);
        else run<3>(acc, u, wr, wc, fr, fq);
    }
};


struct EpiPool {
    static constexpr bool PERM = true, AFTER_DRAIN = false; static constexpr int MID_T = -1;
    bf16_t* act; const float* scale;
    __device__ __forceinline__ void mid(Acc&, const Unit&, int, int, int, int) const {}
    __device__ __forceinline__ void operator()(Acc& acc, const Unit& u, int wr, int wc, int fr, int fq) const {
        int row0 = u.pm * 256 + wr * 64 + fr, col0 = u.pn * 256 + wc * 32 + 8 * fq; asm volatile("" : "+v"(row0), "+v"(col0));
        f32x4 sc[2][2];
#pragma unroll
        for (int bj = 0; bj < 2; ++bj) { sc[bj][0] = *(const f32x4*)(scale + col0 + bj * 128); sc[bj][1] = *(const f32x4*)(scale + col0 + bj * 128 + 4); }
#pragma unroll
        for (int ai = 0; ai < 2; ++ai)
#pragma unroll
            for (int m = 0; m < 4; ++m) {
                bf16_t* rowp = act + (size_t)(row0 + ai * 128 + m * 16) * DIN + C_ZB + col0;
#pragma unroll
                for (int bj = 0; bj < 2; ++bj) {
                    const u32x4 z = *(const u32x4*)(rowp + bj * 128);
                    const f32x4 v0 = acc[ai][bj][m][0] * sc[bj][0], v1 = acc[ai][bj][m][1] * sc[bj][1];
                    u32x4 w;
                    w.x = cvt_pk_bf16(v0[0] * bf_lo(z.x), v0[1] * bf_hi(z.x)); w.y = cvt_pk_bf16(v0[2] * bf_lo(z.y), v0[3] * bf_hi(z.y));
                    w.z = cvt_pk_bf16(v1[0] * bf_lo(z.z), v1[1] * bf_hi(z.z)); w.w = cvt_pk_bf16(v1[2] * bf_lo(z.w), v1[3] * bf_hi(z.w));
                    *(u32x4*)(rowp + bj * 128) = w;
                }
                if (m == 3) asm volatile("" ::: "memory");
            }
    }
};

struct EpiMerge {
    static constexpr bool PERM = true, AFTER_DRAIN = false; static constexpr int MID_T = 16;
    bf16_t* act;
    __device__ __forceinline__ void mid(Acc& acc, const Unit& u, int wr, int wc, int fr, int fq) const {
        int row0 = u.pm * 256 + wr * 64 + fr, col0 = u.pn * 256 + wc * 32 + 8 * fq; asm volatile("" : "+v"(row0), "+v"(col0));
#pragma unroll
        for (int ai = 0; ai < 2; ++ai)
#pragma unroll
            for (int m = 0; m < 4; ++m) {
                const bf16_t* rowp = act + (size_t)(row0 + ai * 128 + m * 16) * DIN + col0;
#pragma unroll
                for (int bj = 0; bj < 2; ++bj) {
                    const u32x4 ga = *(const u32x4*)(rowp + C_GA + bj * 128), gb = *(const u32x4*)(rowp + C_GB + bj * 128);
                    f32x4 r0, r1;
                    r0[0] = bf_lo(ga.x) * __builtin_amdgcn_rcpf(fmaxf(bf_lo(gb.x), 1e-30f)); r0[1] = bf_hi(ga.x) * __builtin_amdgcn_rcpf(fmaxf(bf_hi(gb.x), 1e-30f));
                    r0[2] = bf_lo(ga.y) * __builtin_amdgcn_rcpf(fmaxf(bf_lo(gb.y), 1e-30f)); r0[3] = bf_hi(ga.y) * __builtin_amdgcn_rcpf(fmaxf(bf_hi(gb.y), 1e-30f));
                    r1[0] = bf_lo(ga.z) * __builtin_amdgcn_rcpf(fmaxf(bf_lo(gb.z), 1e-30f)); r1[1] = bf_hi(ga.z) * __builtin_amdgcn_rcpf(fmaxf(bf_hi(gb.z), 1e-30f));
                    r1[2] = bf_lo(ga.w) * __builtin_amdgcn_rcpf(fmaxf(bf_lo(gb.w), 1e-30f)); r1[3] = bf_hi(ga.w) * __builtin_amdgcn_rcpf(fmaxf(bf_hi(gb.w), 1e-30f));
                    acc[ai][bj][m][0] *= r0; acc[ai][bj][m][1] *= r1;
                }
                if (m & 1) asm volatile("" ::: "memory");
            }
    }
    __device__ __forceinline__ void operator()(Acc& acc, const Unit& u, int wr, int wc, int fr, int fq) const {
        int row0 = u.pm * 256 + wr * 64 + fr, col0 = u.pn * 256 + wc * 32 + 8 * fq; asm volatile("" : "+v"(row0), "+v"(col0));
#pragma unroll
        for (int ai = 0; ai < 2; ++ai)
#pragma unroll
            for (int m = 0; m < 4; ++m) {
                bf16_t* rowp = act + (size_t)(row0 + ai * 128 + m * 16) * DIN + col0;
#pragma unroll
                for (int bj = 0; bj < 2; ++bj) {
                    const u32x4 gb = *(const u32x4*)(rowp + C_GB + bj * 128);
                    const f32x4 v0 = acc[ai][bj][m][0], v1 = acc[ai][bj][m][1];
                    u32x4 w;
                    w.x = cvt_pk_bf16(v0[0] * bf_lo(gb.x), v0[1] * bf_hi(gb.x)); w.y = cvt_pk_bf16(v0[2] * bf_lo(gb.y), v0[3] * bf_hi(gb.y));
                    w.z = cvt_pk_bf16(v1[0] * bf_lo(gb.z), v1[1] * bf_hi(gb.z)); w.w = cvt_pk_bf16(v1[2] * bf_lo(gb.w), v1[3] * bf_hi(gb.w));
                    *(u32x4*)(rowp + C_M + bj * 128) = w;
                }
                if (m == 3) asm volatile("" ::: "memory");
            }
    }
};

struct EpiOut {
    static constexpr bool PERM = true, AFTER_DRAIN = false; static constexpr int MID_T = -1;
    bf16_t* act; float* statt;
    __device__ __forceinline__ void mid(Acc&, const Unit&, int, int, int, int) const {}
    __device__ __forceinline__ void operator()(Acc& acc, const Unit& u, int wr, int wc, int fr, int fq) const {
        int row0 = u.pm * 256 + wr * 64 + fr, col0 = u.pn * 256 + wc * 32 + 8 * fq; asm volatile("" : "+v"(row0), "+v"(col0));
#pragma unroll
        for (int ai = 0; ai < 2; ++ai)
#pragma unroll
            for (int m = 0; m < 4; ++m) {
                const int row = row0 + ai * 128 + m * 16;
                bf16_t* rowp = act + (size_t)row * DIN + C_T + col0;
                float q = 0.f;
#pragma unroll
                for (int bj = 0; bj < 2; ++bj) {
                    const f32x4 v0 = acc[ai][bj][m][0], v1 = acc[ai][bj][m][1];
                    q += (v0[0] * v0[0] + v0[1] * v0[1]) + (v0[2] * v0[2] + v0[3] * v0[3]) + (v1[0] * v1[0] + v1[1] * v1[1]) + (v1[2] * v1[2] + v1[3] * v1[3]);
                    u32x4 w; w.x = cvt_pk_bf16(v0[0], v0[1]); w.y = cvt_pk_bf16(v0[2], v0[3]); w.z = cvt_pk_bf16(v1[0], v1[1]); w.w = cvt_pk_bf16(v1[2], v1[3]);
                    *(u32x4*)(rowp + bj * 128) = w;
                }
                q += __shfl_xor(q, 16); q += __shfl_xor(q, 32);
                if (fq == 0) statt[(size_t)row * 16 + u.pn * 4 + wc] = q;
            }
    }
};

struct EpiGate {
    static constexpr bool PERM = true, AFTER_DRAIN = false; static constexpr int MID_T = 4;
    bf16_t* act; float* statg;
    __device__ __forceinline__ void mid(Acc& acc, const Unit& u, int wr, int wc, int fr, int fq) const {
        int row0 = u.pm * 256 + wr * 64 + fr, col0 = u.pn * 256 + wc * 32 + 8 * fq; asm volatile("" : "+v"(row0), "+v"(col0));
#pragma unroll
        for (int ai = 0; ai < 2; ++ai)
#pragma unroll
            for (int m = 0; m < 4; ++m) {
                bf16_t* rowp = act + (size_t)(row0 + ai * 128 + m * 16) * DIN + C_E + col0;
#pragma unroll
                for (int bj = 0; bj < 2; ++bj) {
                    const f32x4 v0 = acc[ai][bj][m][0], v1 = acc[ai][bj][m][1];
                    u32x4 w; w.x = cvt_pk_bf16(v0[0], v0[1]); w.y = cvt_pk_bf16(v0[2], v0[3]); w.z = cvt_pk_bf16(v1[0], v1[1]); w.w = cvt_pk_bf16(v1[2], v1[3]);
                    *(u32x4*)(rowp + bj * 128) = w;
                    acc[ai][bj][m][0] = (f32x4){0.f, 0.f, 0.f, 0.f}; acc[ai][bj][m][1] = (f32x4){0.f, 0.f, 0.f, 0.f};
                }
            }
    }
    __device__ __forceinline__ void operator()(Acc& acc, const Unit& u, int wr, int wc, int fr, int fq) const {
        int row0 = u.pm * 256 + wr * 64 + fr, col0 = u.pn * 256 + wc * 32 + 8 * fq; asm volatile("" : "+v"(row0), "+v"(col0));
#pragma unroll
        for (int ai = 0; ai < 2; ++ai)
#pragma unroll
            for (int m = 0; m < 4; ++m) {
                const int row = row0 + ai * 128 + m * 16;
                const bf16_t* erow = act + (size_t)row * DIN + C_E + col0;
                bf16_t* grow = act + (size_t)row * DIN + C_GE + col0;
                float q = 0.f;
#pragma unroll
                for (int bj = 0; bj < 2; ++bj) {
                    const u32x4 e = *(const u32x4*)(erow + bj * 128);
                    const f32x4 a0 = acc[ai][bj][m][0], a1 = acc[ai][bj][m][1];
                    f32x4 v0, v1;
                    v0[0] = sigm(a0[0]) * bf_lo(e.x); v0[1] = sigm(a0[1]) * bf_hi(e.x); v0[2] = sigm(a0[2]) * bf_lo(e.y); v0[3] = sigm(a0[3]) * bf_hi(e.y);
                    v1[0] = sigm(a1[0]) * bf_lo(e.z); v1[1] = sigm(a1[1]) * bf_hi(e.z); v1[2] = sigm(a1[2]) * bf_lo(e.w); v1[3] = sigm(a1[3]) * bf_hi(e.w);
#pragma unroll
                    for (int j = 0; j < 4; ++j) q += v0[j] * v0[j] + v1[j] * v1[j];
                    u32x4 w; w.x = cvt_pk_bf16(v0[0], v0[1]); w.y = cvt_pk_bf16(v0[2], v0[3]); w.z = cvt_pk_bf16(v1[0], v1[1]); w.w = cvt_pk_bf16(v1[2], v1[3]);
                    *(u32x4*)(grow + bj * 128) = w;
                }
                q += __shfl_xor(q, 16); q += __shfl_xor(q, 32);
                if (fq == 0) statg[(size_t)row * 16 + u.pn * 4 + wc] = q;
                asm volatile("" ::: "memory");
            }
    }
};


struct RowX {
    float* xbuf; unsigned* cnt;
    __device__ __forceinline__ void put(int k, float q, int wr, int wc, int fr, int fq, LAS unsigned char* lds) const {
        LAS float* P = (LAS float*)lds;
        q += __shfl_xor(q, 16); q += __shfl_xor(q, 32);
        if (fq == 0) P[((k >> 2) * 128 + wr * 64 + (k & 3) * 16 + fr) * 4 + wc] = q;
    }
    __device__ __forceinline__ void exchange(const Unit& u, LAS unsigned char* lds, int wid, int lane) const {
        LAS float* P = (LAS float*)lds; LAS float* S = (LAS float*)(lds + 4096);
        asm volatile("s_waitcnt lgkmcnt(0)" ::: "memory"); __builtin_amdgcn_s_barrier(); asm volatile("" ::: "memory");
        const int row = wid * 32 + (lane & 31);
        if (lane < 32) {
            const float t = (P[row * 4] + P[row * 4 + 1]) + (P[row * 4 + 2] + P[row * 4 + 3]);
            __hip_atomic_store(xbuf + ((size_t)(u.pm * 256 + row) * 4 + u.pn), t, __ATOMIC_RELAXED, __HIP_MEMORY_SCOPE_AGENT);
        }
        asm volatile("s_waitcnt vmcnt(0)" ::: "memory");
        if (lane == 0) __hip_atomic_fetch_add(cnt + 64 * u.pm, 1u, __ATOMIC_RELAXED, __HIP_MEMORY_SCOPE_AGENT);
        if (wid == 0) {
            unsigned sp = 0;
            while ((unsigned)__builtin_amdgcn_readfirstlane(__hip_atomic_load(cnt + 64 * u.pm, __ATOMIC_RELAXED, __HIP_MEMORY_SCOPE_AGENT)) < 32u) { __builtin_amdgcn_s_sleep(2); if (++sp > (1u << 22)) break; }
            __builtin_amdgcn_fence(__ATOMIC_ACQUIRE, "agent");
        }
        asm volatile("s_waitcnt vmcnt(0) lgkmcnt(0)" ::: "memory"); __builtin_amdgcn_s_barrier(); asm volatile("" ::: "memory");
        if (lane < 32) {
            float* slot = xbuf + (size_t)(u.pm * 256 + row) * 4; float s = 0.f;
#pragma unroll
            for (int t = 0; t < 4; ++t) s += __hip_atomic_load(slot + t, __ATOMIC_RELAXED, __HIP_MEMORY_SCOPE_AGENT);
            S[row] = 1.0f / sqrtf(s * (1.0f / DM) + EPS);
        }
        asm volatile("s_waitcnt lgkmcnt(0)" ::: "memory"); __builtin_amdgcn_s_barrier(); asm volatile("" ::: "memory");
    }
};
struct EpiOutF {
    static constexpr bool PERM = true, AFTER_DRAIN = true; static constexpr int MID_T = -1;
    bf16_t* act; const float* x; float* rstd1g; const float* post_g; const float* ple_in_g; RowX X1, X2;
    __device__ __forceinline__ void mid(Acc&, const Unit&, int, int, int, int) const {}
    __device__ __forceinline__ void operator()(Acc&, const Unit&, int, int, int, int) const {}
    __device__ __forceinline__ void fused(Acc& acc, const Unit& u, int wr, int wc, int fr, int fq, LAS unsigned char* lds, int wid, int lane) const {
        int row0 = u.pm * 256 + wr * 64 + fr, col0 = u.pn * 256 + wc * 32 + 8 * fq; asm volatile("" : "+v"(row0), "+v"(col0));
        const LAS float* S = (const LAS float*)(lds + 4096);
#pragma unroll
        for (int k = 0; k < 8; ++k) { float q = 0.f;
#pragma unroll
            for (int bj = 0; bj < 2; ++bj)
#pragma unroll
                for (int n = 0; n < 2; ++n) { const f32x4 v = acc[k >> 2][bj][k & 3][n]; q += (v[0] * v[0] + v[1] * v[1]) + (v[2] * v[2] + v[3] * v[3]); }
            X1.put(k, q, wr, wc, fr, fq, lds); }
        X1.exchange(u, lds, wid, lane);
#pragma unroll
        for (int k = 0; k < 8; ++k) {
            const int ai = k >> 2, m = k & 3, rl = ai * 128 + wr * 64 + m * 16 + fr; const float rstd = S[rl];
            const unsigned off = (unsigned)((row0 + ai * 128 + m * 16) * DM + col0) * 4u; float q = 0.f;
#pragma unroll
            for (int bj = 0; bj < 2; ++bj)
#pragma unroll
                for (int n = 0; n < 2; ++n) {
                    const f32x4 hv = *(const f32x4*)((const char*)x + off + (bj * 128 + 4 * n) * 4), gv = *(const f32x4*)(post_g + col0 + bj * 128 + 4 * n);
                    const f32x4 h1 = hv + acc[ai][bj][m][n] * rstd * gv;
                    acc[ai][bj][m][n] = h1; q += (h1[0] * h1[0] + h1[1] * h1[1]) + (h1[2] * h1[2] + h1[3] * h1[3]);
                }
            X2.put(k, q, wr, wc, fr, fq, lds + 8192);
            asm volatile("" : "+v"(acc[ai][0][m][0]), "+v"(acc[ai][0][m][1]), "+v"(acc[ai][1][m][0]), "+v"(acc[ai][1][m][1]));
            if (k & 1) asm volatile("" ::: "memory");
        }
        X2.exchange(u, lds + 8192, wid, lane);
        const LAS float* S2 = (const LAS float*)(lds + 8192 + 4096);
        if (u.pn == 0 && lane < 32) rstd1g[u.pm * 256 + wid * 32 + lane] = S2[wid * 32 + lane];
#pragma unroll
        for (int k = 0; k < 8; ++k) {
            const int ai = k >> 2, m = k & 3, rl = ai * 128 + wr * 64 + m * 16 + fr; const float rstd1 = S2[rl];
            const unsigned off = (unsigned)((row0 + ai * 128 + m * 16) * DIN + PLE + col0) * 2u;
#pragma unroll
            for (int bj = 0; bj < 2; ++bj) {
                const f32x4 g0 = *(const f32x4*)(ple_in_g + col0 + bj * 128), g1 = *(const f32x4*)(ple_in_g + col0 + bj * 128 + 4);
                const f32x4 v0 = acc[ai][bj][m][0] * rstd1 * g0, v1 = acc[ai][bj][m][1] * rstd1 * g1;
                u32x4 w; w.x = cvt_pk_bf16(v0[0], v0[1]); w.y = cvt_pk_bf16(v0[2], v0[3]); w.z = cvt_pk_bf16(v1[0], v1[1]); w.w = cvt_pk_bf16(v1[2], v1[3]);
                *(u32x4*)((char*)act + off + bj * 256) = w;
            }
            if ((k & 3) == 3) asm volatile("" ::: "memory");
        }
    }
};
struct EpiGateF {
    static constexpr bool PERM = true, AFTER_DRAIN = true; static constexpr int MID_T = 4;
    bf16_t* act; float* out; const float* g; const float* gin; const float* rstd1g; RowX X;
    __device__ __forceinline__ void operator()(Acc&, const Unit&, int, int, int, int) const {}
    __device__ __forceinline__ void mid(Acc& acc, const Unit& u, int wr, int wc, int fr, int fq) const {
        int row0 = u.pm * 256 + wr * 64 + fr, col0 = u.pn * 256 + wc * 32 + 8 * fq; asm volatile("" : "+v"(row0), "+v"(col0));
#pragma unroll
        for (int ai = 0; ai < 2; ++ai)
#pragma unroll
            for (int m = 0; m < 4; ++m) {
                bf16_t* rowp = act + (size_t)(row0 + ai * 128 + m * 16) * DIN + C_E + col0;
#pragma unroll
                for (int bj = 0; bj < 2; ++bj) {
                    const f32x4 v0 = acc[ai][bj][m][0], v1 = acc[ai][bj][m][1];
                    u32x4 w; w.x = cvt_pk_bf16(v0[0], v0[1]); w.y = cvt_pk_bf16(v0[2], v0[3]); w.z = cvt_pk_bf16(v1[0], v1[1]); w.w = cvt_pk_bf16(v1[2], v1[3]);
                    *(u32x4*)(rowp + bj * 128) = w;
                    acc[ai][bj][m][0] = (f32x4){0.f, 0.f, 0.f, 0.f}; acc[ai][bj][m][1] = (f32x4){0.f, 0.f, 0.f, 0.f};
                }
            }
    }
    __device__ __forceinline__ void fused(Acc& acc, const Unit& u, int wr, int wc, int fr, int fq, LAS unsigned char* lds, int wid, int lane) const {
        int row0 = u.pm * 256 + wr * 64 + fr, col0 = u.pn * 256 + wc * 32 + 8 * fq; asm volatile("" : "+v"(row0), "+v"(col0));
        const LAS float* S = (const LAS float*)(lds + 4096);
#pragma unroll
        for (int k = 0; k < 8; ++k) {
            const int ai = k >> 2, m = k & 3;
            const unsigned eoff = (unsigned)((row0 + ai * 128 + m * 16) * DIN + C_E + col0) * 2u; float q = 0.f;
#pragma unroll
            for (int bj = 0; bj < 2; ++bj) {
                const u32x4 e = *(const u32x4*)((const char*)act + eoff + bj * 256);
                const f32x4 a0 = acc[ai][bj][m][0], a1 = acc[ai][bj][m][1];
                f32x4 v0, v1;
                v0[0] = sigm(a0[0]) * bf_lo(e.x); v0[1] = sigm(a0[1]) * bf_hi(e.x); v0[2] = sigm(a0[2]) * bf_lo(e.y); v0[3] = sigm(a0[3]) * bf_hi(e.y);
                v1[0] = sigm(a1[0]) * bf_lo(e.z); v1[1] = sigm(a1[1]) * bf_hi(e.z); v1[2] = sigm(a1[2]) * bf_lo(e.w); v1[3] = sigm(a1[3]) * bf_hi(e.w);
#pragma unroll
                for (int j = 0; j < 4; ++j) q += v0[j] * v0[j] + v1[j] * v1[j];
                acc[ai][bj][m][0] = v0; acc[ai][bj][m][1] = v1;
            }
            X.put(k, q, wr, wc, fr, fq, lds);
            asm volatile("" : "+v"(acc[ai][0][m][0]), "+v"(acc[ai][0][m][1]), "+v"(acc[ai][1][m][0]), "+v"(acc[ai][1][m][1]));
            if (k & 1) asm volatile("" ::: "memory");
        }
        X.exchange(u, lds, wid, lane);
        f32x4 ig[2][2];
#pragma unroll
        for (int bj = 0; bj < 2; ++bj)
#pragma unroll
            for (int n = 0; n < 2; ++n) { const f32x4 gi = *(const f32x4*)(gin + col0 + bj * 128 + 4 * n);
                ig[bj][n] = (f32x4){__builtin_amdgcn_rcpf(gi[0]), __builtin_amdgcn_rcpf(gi[1]), __builtin_amdgcn_rcpf(gi[2]), __builtin_amdgcn_rcpf(gi[3])}; }
#pragma unroll
        for (int k = 0; k < 8; ++k) {
            const int ai = k >> 2, m = k & 3, rl = ai * 128 + wr * 64 + m * 16 + fr; const float rstd = S[rl];
            const int row = row0 + ai * 128 + m * 16;
            const float ir1 = __builtin_amdgcn_rcpf(rstd1g[row]);
            const unsigned off = (unsigned)(row * DM + col0) * 4u, hoff = (unsigned)(row * DIN + PLE + col0) * 2u;
#pragma unroll
            for (int bj = 0; bj < 2; ++bj) {
                const u32x4 hn = *(const u32x4*)((const char*)act + hoff + bj * 256);
                const f32x4 h0 = (f32x4){bf_lo(hn.x), bf_hi(hn.x), bf_lo(hn.y), bf_hi(hn.y)} * ig[bj][0] * ir1, h1v = (f32x4){bf_lo(hn.z), bf_hi(hn.z), bf_lo(hn.w), bf_hi(hn.w)} * ig[bj][1] * ir1;
                const f32x4 g0 = *(const f32x4*)(g + col0 + bj * 128), g1 = *(const f32x4*)(g + col0 + bj * 128 + 4);
                *(f32x4*)((char*)out + off + (bj * 128) * 4) = h0 + acc[ai][bj][m][0] * rstd * g0;
                *(f32x4*)((char*)out + off + (bj * 128 + 4) * 4) = h1v + acc[ai][bj][m][1] * rstd * g1;
            }
            if (k & 1) asm volatile("" ::: "memory");
        }
    }
};

template <int NT>
__device__ __forceinline__ void small_gemm1(const Params& p, const bf16_t* A, int lda, const bf16_t* Bt, int ldb, int K, int nstrips) {
    const int tid = threadIdx.x, lane = tid & 63, wid = __builtin_amdgcn_readfirstlane(tid >> 6), fr = lane & 15, fq = lane >> 4;
    bf16_t* act = (bf16_t*)(p.ws + WS_ACT);
    for (int u = blockIdx.x; u < nstrips; u += gridDim.x) {
        const int n0 = u * 16 * NT, r = wid * 16 + fr, row = MPR + r;
        const bf16_t* ap = A + (size_t)row * lda + 8 * fq;
        const bf16_t* bp = Bt + (size_t)(n0 + fr) * ldb + 8 * fq;
        bf16_t* arow = act + (size_t)row * DIN;
        f32x4 acc[NT];
#pragma unroll
        for (int t = 0; t < NT; ++t) acc[t] = (f32x4){0.f, 0.f, 0.f, 0.f};
        for (int k0 = 0; k0 < K; k0 += 256) {
            bf16x8 a[8], b[NT][8];
#pragma unroll
            for (int j = 0; j < 8; ++j) { a[j] = *(const bf16x8*)(ap + k0 + 32 * j);
#pragma unroll
                for (int t = 0; t < NT; ++t) b[t][j] = *(const bf16x8*)(bp + (size_t)t * 16 * ldb + k0 + 32 * j); }
#pragma unroll
            for (int j = 0; j < 8; ++j)
#pragma unroll
                for (int t = 0; t < NT; ++t) acc[t] = __builtin_amdgcn_mfma_f32_16x16x32_bf16(b[t][j], a[j], acc[t], 0, 0, 0);
        }
#pragma unroll
        for (int t = 0; t < NT; ++t) {
            const int nt0 = n0 + 16 * t, col = nt0 + 4 * fq, blk = nt0 >> 10; f32x4 v = acc[t];
            if (blk == 2) { v[0] = gelu_t(v[0]); v[1] = gelu_t(v[1]); v[2] = gelu_t(v[2]); v[3] = gelu_t(v[3]); }
            else if (blk == 1) { v[0] *= sigm(v[0]); v[1] *= sigm(v[1]); v[2] *= sigm(v[2]); v[3] *= sigm(v[3]); }
            else if (blk >= 5) { v[0] = sigm(v[0]); v[1] = sigm(v[1]); v[2] = sigm(v[2]); v[3] = sigm(v[3]); }
            u32x2 w; w.x = cvt_pk_bf16(v[0], v[1]); w.y = cvt_pk_bf16(v[2], v[3]);
            *(u32x2*)(arow + col) = w;
            if (blk == 2) {
                float s = (v[0] + v[1]) + (v[2] + v[3]), q = (v[0] * v[0] + v[1] * v[1]) + (v[2] * v[2] + v[3] * v[3]);
                s += __shfl_xor(s, 16); s += __shfl_xor(s, 32); q += __shfl_xor(q, 16); q += __shfl_xor(q, 32);
                if (fq == 0) *(f32x2*)((float*)(p.ws + WS_SVS) + ((size_t)r * 64 + ((nt0 & 1023) >> 4)) * 2) = (f32x2){s, q};
            }
            if (blk == 4) *(f32x4*)(p.out + O_SP + ((size_t)r * 15 + 14) * DM + (col & 1023)) = v;
        }
    }
}

template <int MODE>
__device__ __forceinline__ void small2(LAS unsigned char* lds, const Params& p, const bf16_t* A, int lda, const bf16_t* Bt, int ldb) {
    const int tid = threadIdx.x, lane = tid & 63, wid = __builtin_amdgcn_readfirstlane(tid >> 6), fr = lane & 15, fq = lane >> 4, rt = wid & 1, kq = wid >> 1;
    bf16_t* act = (bf16_t*)(p.ws + WS_ACT);
    LAS f32x4* red = (LAS f32x4*)lds;
    for (int u = blockIdx.x; u < 256; u += gridDim.x) {
        const int strip = u & 63, n0 = strip * 16, r = (u >> 6) * 32 + rt * 16 + fr, row = MPR + r, col = n0 + 4 * fq;
        const bf16_t* ap = A + (size_t)row * lda + 8 * fq + (MODE == 2 ? (n0 >> 8) * 256 : 0);
        const bf16_t* bp = Bt + (size_t)(n0 + fr) * ldb + 8 * fq;
        bf16_t* arow = act + (size_t)row * DIN;
        f32x4 acc = (f32x4){0.f, 0.f, 0.f, 0.f}, e4 = (f32x4){0.f, 0.f, 0.f, 0.f};
        if (MODE == 2) {
            bf16x8 a[2], b[2];
#pragma unroll
            for (int j = 0; j < 2; ++j) { a[j] = *(const bf16x8*)(ap + kq * 64 + 32 * j); b[j] = *(const bf16x8*)(bp + kq * 64 + 32 * j); }
#pragma unroll
            for (int j = 0; j < 2; ++j) acc = __builtin_amdgcn_mfma_f32_16x16x32_bf16(b[j], a[j], acc, 0, 0, 0);
        } else {
            constexpr int NB = MODE == 3 ? 2 : 1;
            const int kbase = MODE == 3 ? kq * 512 : MODE == 4 ? kq * 256 : 256 + kq * 256;
            if (MODE == 6 && kq == 0) {
                bf16x8 a[8], b[8];
#pragma unroll
                for (int j = 0; j < 8; ++j) { a[j] = *(const bf16x8*)(ap + 32 * j); b[j] = *(const bf16x8*)(bp + 32 * j); }
#pragma unroll
                for (int j = 0; j < 8; ++j) e4 = __builtin_amdgcn_mfma_f32_16x16x32_bf16(b[j], a[j], e4, 0, 0, 0);
            }
#pragma unroll
            for (int bt = 0; bt < NB; ++bt) {
                bf16x8 a[8], b[8];
#pragma unroll
                for (int j = 0; j < 8; ++j) { a[j] = *(const bf16x8*)(ap + kbase + bt * 256 + 32 * j); b[j] = *(const bf16x8*)(bp + kbase + bt * 256 + 32 * j); }
#pragma unroll
                for (int j = 0; j < 8; ++j) acc = __builtin_amdgcn_mfma_f32_16x16x32_bf16(b[j], a[j], acc, 0, 0, 0);
            }
        }
        red[wid * 64 + lane] = acc;
        __syncthreads();
        if (kq == 0) {
            const f32x4 p1 = red[(rt + 2) * 64 + lane], p2 = red[(rt + 4) * 64 + lane], p3 = red[(rt + 6) * 64 + lane];
            f32x4 v;
            if (MODE == 3) {
                const u32x2 ga = *(const u32x2*)(arow + C_GA + col), gb = *(const u32x2*)(arow + C_GB + col);
                const f32x4 ya = acc + p1, yb = p2 + p3;
                v[0] = ya[0] * bf_lo(ga.x) + yb[0] * bf_lo(gb.x); v[1] = ya[1] * bf_hi(ga.x) + yb[1] * bf_hi(gb.x);
                v[2] = ya[2] * bf_lo(ga.y) + yb[2] * bf_lo(gb.y); v[3] = ya[3] * bf_hi(ga.y) + yb[3] * bf_hi(gb.y);
                u32x2 w; w.x = cvt_pk_bf16(v[0], v[1]); w.y = cvt_pk_bf16(v[2], v[3]);
                *(u32x2*)(arow + C_M + col) = w;
            } else {
                v = (acc + p1) + (p2 + p3);
                if (MODE == 2) {
                    const u32x2 z = *(const u32x2*)(arow + C_ZB + col); const f32x4 sc = *(const f32x4*)(p.pool_scale + col);
                    u32x2 w; w.x = cvt_pk_bf16(v[0] * sc[0] * bf_lo(z.x), v[1] * sc[1] * bf_hi(z.x)); w.y = cvt_pk_bf16(v[2] * sc[2] * bf_lo(z.y), v[3] * sc[3] * bf_hi(z.y));
                    *(u32x2*)(arow + C_ZB + col) = w;
                } else {
                    if (MODE == 6) { v[0] = sigm(v[0]) * e4[0]; v[1] = sigm(v[1]) * e4[1]; v[2] = sigm(v[2]) * e4[2]; v[3] = sigm(v[3]) * e4[3]; }
                    { const unsigned w0 = cvt_pk_bf16(v[0], v[1]), w1 = cvt_pk_bf16(v[2], v[3]);
                      __hip_atomic_store((unsigned long long*)(arow + (MODE == 4 ? C_T : C_GE) + col), ((unsigned long long)w1 << 32) | w0, __ATOMIC_RELAXED, __HIP_MEMORY_SCOPE_AGENT); }
                    float q = (v[0] * v[0] + v[1] * v[1]) + (v[2] * v[2] + v[3] * v[3]);
                    q += __shfl_xor(q, 16); q += __shfl_xor(q, 32);
                    if (fq == 0) __hip_atomic_store((float*)(p.ws + (MODE == 4 ? WS_STS : WS_SGS)) + (size_t)r * 64 + strip, q, __ATOMIC_RELAXED, __HIP_MEMORY_SCOPE_AGENT);
                }
            }
        }
        if (MODE == 4 || MODE == 6) {
            asm volatile("s_waitcnt vmcnt(0)" ::: "memory");
            __syncthreads();
            if (tid == 0) __hip_atomic_fetch_add((unsigned*)(p.ws + WS_TICK) + ((MODE == 4 ? 0 : 4) + (u >> 6)) * 64, 1u, __ATOMIC_RELAXED, __HIP_MEMORY_SCOPE_AGENT);
        }
        __syncthreads();
    }
}

template <int MODE> struct PreSmall2 {
    LAS unsigned char* lds; const Params& p; const bf16_t* A; int lda; const bf16_t* Bt; int ldb;
    __device__ __forceinline__ void operator()() const { small2<MODE>(lds + 131072 + 64, p, A, lda, Bt, ldb); }
};

__device__ __forceinline__ void transpose_tile(LAS unsigned char* lds, const float* src, int lds_src, int k0, int n0, bf16_t* dst, int ldd, int drow0, int dcol0) {
    LAS bf16_t* T = (LAS bf16_t*)lds;
    const int tid = threadIdx.x;
#pragma unroll
    for (int i = 0; i < 2; ++i) {
        const int r = (tid >> 4) + 32 * i, c4 = (tid & 15) * 4;
        const f32x4 v = *(const f32x4*)(src + (size_t)(k0 + r) * lds_src + n0 + c4);
        const unsigned p01 = cvt_pk_bf16(v[0], v[1]), p23 = cvt_pk_bf16(v[2], v[3]);
        T[(c4 + 0) * 72 + r] = (bf16_t)(p01 & 0xffffu); T[(c4 + 1) * 72 + r] = (bf16_t)(p01 >> 16);
        T[(c4 + 2) * 72 + r] = (bf16_t)(p23 & 0xffffu); T[(c4 + 3) * 72 + r] = (bf16_t)(p23 >> 16);
    }
    __syncthreads();
    {
        const int n = tid >> 3, kc = (tid & 7) * 8;
        const u32x4 w = *(const LAS u32x4*)(T + n * 72 + kc);
        *(u32x4*)(dst + (size_t)(drow0 + n) * ldd + dcol0 + kc) = w;
    }
    __syncthreads();
}

__device__ __forceinline__ void phase_prep(LAS unsigned char* lds, const Params& p) {
    const int tid = threadIdx.x, lane = tid & 63, wid = tid >> 6, G = gridDim.x, bid = blockIdx.x;
    bf16_t* XN = (bf16_t*)((unsigned char*)p.out + DO_XN);
    bf16_t* WinT = (bf16_t*)((unsigned char*)p.out + DO_WIN);
    bf16_t* WcatT = (bf16_t*)(p.ws + WS_WCAT); bf16_t* WoutT = (bf16_t*)(p.ws + WS_WOUT); bf16_t* W6T = (bf16_t*)(p.ws + WS_W6);
    bf16_t* WpoolT = (bf16_t*)(p.ws + WS_WPOOL); bf16_t* WsB = (bf16_t*)(p.ws + WS_WS);
    for (int row = bid * 8 + wid; row < MREAL; row += G * 8) {
        bf16_t* dst = XN + (size_t)row * DM;
        const float* src = row < MPR ? p.x_prompt + (size_t)row * DM : p.x_sample + (size_t)(row - MPR) * DM;
        f32x4 v[4]; float ss = 0.f;
#pragma unroll
        for (int i = 0; i < 4; ++i) { v[i] = *(const f32x4*)(src + lane * 4 + 256 * i); ss += (v[i][0] * v[i][0] + v[i][1] * v[i][1]) + (v[i][2] * v[i][2] + v[i][3] * v[i][3]); }
        ss = wave_sum(ss);
        const float rstd = 1.0f / sqrtf(ss * (1.0f / DM) + EPS);
#pragma unroll
        for (int i = 0; i < 4; ++i) {
            const f32x4 g = *(const f32x4*)(p.pre_g + lane * 4 + 256 * i);
            u32x2 w; w.x = cvt_pk_bf16(v[i][0] * rstd * g[0], v[i][1] * rstd * g[1]); w.y = cvt_pk_bf16(v[i][2] * rstd * g[2], v[i][3] * rstd * g[3]);
            *(u32x2*)(dst + lane * 4 + 256 * i) = w;
        }
    }
    constexpr int T_IN = 16 * 112, T_SQ = 256, T_PLE = 64, T_POOL = 64, T_ALL = T_IN + 4 * T_SQ + T_PLE + T_POOL;
    for (int it = bid; it < T_ALL; it += G) {
        int r = it;
        if (r < T_IN) {
            const int kt = r / 112, ntile = r % 112, n0 = ntile * 64, sb = n0 >> 10;
            const int db = sb == 0 ? 0 : sb == 1 ? 2 : sb == 2 ? 3 : sb == 3 ? 4 : sb == 4 ? 1 : sb;
            transpose_tile(lds, p.w_in, DIN, kt * 64, n0, WinT, DM, db * 1024 + (n0 & 1023), kt * 64); continue; }
        r -= T_IN;
        if (r < T_SQ) { transpose_tile(lds, p.w_pa, DM, (r >> 4) * 64, (r & 15) * 64, WcatT, 2048, (r & 15) * 64, (r >> 4) * 64); continue; } r -= T_SQ;
        if (r < T_SQ) { transpose_tile(lds, p.w_pb, DM, (r >> 4) * 64, (r & 15) * 64, WcatT, 2048, (r & 15) * 64, 1024 + (r >> 4) * 64); continue; } r -= T_SQ;
        if (r < T_SQ) { transpose_tile(lds, p.w_out, DM, (r >> 4) * 64, (r & 15) * 64, WoutT, 1024, (r & 15) * 64, (r >> 4) * 64); continue; } r -= T_SQ;
        if (r < T_SQ) { transpose_tile(lds, p.w_pg, DM, (r >> 4) * 64, (r & 15) * 64, W6T, 1280, (r & 15) * 64, 256 + (r >> 4) * 64); continue; } r -= T_SQ;
        if (r < T_PLE) { transpose_tile(lds, p.w_ple, DM, (r >> 4) * 64, (r & 15) * 64, W6T, 1280, (r & 15) * 64, (r >> 4) * 64); continue; } r -= T_PLE;
        { const int g = r >> 4, q = r & 15; transpose_tile(lds, p.w_pool + (size_t)g * 65536, 256, (q >> 2) * 64, (q & 3) * 64, WpoolT + (size_t)g * 65536, 256, (q & 3) * 64, (q >> 2) * 64); }
    }
    const int nb2 = (G == 256) ? 128 : G, b2 = (G == 256) ? bid - 128 : bid;
    if (b2 >= 0) for (int i = b2 * NTHR + tid; i < 8 * 128 * 128 / 4; i += nb2 * NTHR) {
        const int e = i * 4, t = (e >> 7) & 127, s = e & 127;
        const f32x4 v = *(const f32x4*)(p.w_s + e);
        u32x2 w; w.x = cvt_pk_bf16(s + 0 <= t ? v[0] : 0.f, s + 1 <= t ? v[1] : 0.f); w.y = cvt_pk_bf16(s + 2 <= t ? v[2] : 0.f, s + 3 <= t ? v[3] : 0.f);
        *(u32x2*)(WsB + e) = w;
    }
    if (b2 >= 0) for (int i = b2 * NTHR + tid; i < MSM * 14 * DM / 4; i += nb2 * NTHR) {
        const int e = i * 4, b = e / (14 * DM), rem = e % (14 * DM);
        *(f32x4*)(p.out + O_SP + (size_t)b * 15 * DM + rem) = *(const f32x4*)(p.state_pool + (size_t)b * 15 * DM + DM + rem);
    }
}

__device__ __forceinline__ void mix_unit(LAS unsigned char* lds, const Params& p, int c, int h, bool load_w) {
    const int tid = threadIdx.x, lane = tid & 63, wid = __builtin_amdgcn_readfirstlane(tid >> 6), fr = lane & 15, fq = lane >> 4;
    bf16_t* act = (bf16_t*)(p.ws + WS_ACT);
    const float* statv = (const float*)(p.ws + WS_STATV);
    const bf16_t* WsB = (const bf16_t*)(p.ws + WS_WS);
    constexpr int SW = 136, SV = 136;
    LAS bf16_t* Wt = (LAS bf16_t*)lds;
    LAS bf16_t* Vt = (LAS bf16_t*)(lds + 128 * SW * 2);
    LAS float* St = (LAS float*)(lds + 128 * SW * 2 + 128 * SV * 2);
    const int R0 = c * 128, C0 = h * 128, wt = wid >> 1, wd = wid & 1;
    u32x4 wreg[4];
    if (load_w) {
#pragma unroll
        for (int i = 0; i < 4; ++i) { const int idx = tid + i * NTHR, t = idx >> 4, sc = idx & 15; wreg[i] = *(const u32x4*)(WsB + ((size_t)h * 128 + t) * 128 + sc * 8); }
    }
    const f32x4 sv0 = *(const f32x4*)(statv + (size_t)(R0 + (tid >> 2)) * 32 + (tid & 3) * 8), sv1 = *(const f32x4*)(statv + (size_t)(R0 + (tid >> 2)) * 32 + (tid & 3) * 8 + 4);
    u32x4 ra[2], rb[2]; f32x4 lg0[2], lg1[2], lb0[2], lb1[2];
#pragma unroll
    for (int i = 0; i < 2; ++i) {
        const int idx = tid + i * NTHR, sp2 = idx & 63, dc = idx >> 6, s0 = sp2 * 2, d0 = dc * 8;
        ra[i] = *(const u32x4*)(act + (size_t)(R0 + s0) * DIN + C_V + C0 + d0); rb[i] = *(const u32x4*)(act + (size_t)(R0 + s0 + 1) * DIN + C_V + C0 + d0);
        lg0[i] = *(const f32x4*)(p.ln_g + C0 + d0); lg1[i] = *(const f32x4*)(p.ln_g + C0 + d0 + 4); lb0[i] = *(const f32x4*)(p.ln_b + C0 + d0); lb1[i] = *(const f32x4*)(p.ln_b + C0 + d0 + 4);
    }
    u32x2 uu[2][4], za[2][4]; float bs[2];
#pragma unroll
    for (int i = 0; i < 2; ++i) {
        const int t = 32 * wt + 16 * i + fr; bs[i] = p.b_s[h * 128 + t];
        const bf16_t* rowp = act + (size_t)(R0 + t) * DIN + C0 + 64 * wd + 4 * fq;
#pragma unroll
        for (int j = 0; j < 4; ++j) { uu[i][j] = *(const u32x2*)(rowp + C_U + 16 * j); za[i][j] = *(const u32x2*)(rowp + C_ZA + 16 * j); }
    }
    if (load_w) {
#pragma unroll
        for (int i = 0; i < 4; ++i) { const int idx = tid + i * NTHR, t = idx >> 4, sc = idx & 15; *(LAS u32x4*)(Wt + t * SW + sc * 8) = wreg[i]; }
    }
    {
        float s = (sv0[0] + sv0[2]) + (sv1[0] + sv1[2]), q = (sv0[1] + sv0[3]) + (sv1[1] + sv1[3]);
        s += __shfl_xor(s, 1); q += __shfl_xor(q, 1); s += __shfl_xor(s, 2); q += __shfl_xor(q, 2);
        if ((tid & 3) == 0) { const float mean = s * (1.0f / DM), var = fmaxf(q * (1.0f / DM) - mean * mean, 0.f); St[(tid >> 2) * 2] = mean; St[(tid >> 2) * 2 + 1] = 1.0f / sqrtf(var + EPS); }
    }
    __syncthreads();
    const bool last_chunk = (c & 15) == 15;
#pragma unroll
    for (int i = 0; i < 2; ++i) {
        const int idx = tid + i * NTHR, sp2 = idx & 63, dc = idx >> 6, s0 = sp2 * 2, d0 = dc * 8;
        const float ma = St[s0 * 2], ia = St[s0 * 2 + 1], mb = St[s0 * 2 + 2], ib = St[s0 * 2 + 3];
        const f32x4 g0 = lg0[i], g1 = lg1[i], b0 = lb0[i], b1 = lb1[i]; const u32x4 xa = ra[i], xb = rb[i];
        f32x4 a0, a1, c0, c1;
        a0[0] = (bf_lo(xa.x) - ma) * ia * g0[0] + b0[0]; a0[1] = (bf_hi(xa.x) - ma) * ia * g0[1] + b0[1]; a0[2] = (bf_lo(xa.y) - ma) * ia * g0[2] + b0[2]; a0[3] = (bf_hi(xa.y) - ma) * ia * g0[3] + b0[3];
        a1[0] = (bf_lo(xa.z) - ma) * ia * g1[0] + b1[0]; a1[1] = (bf_hi(xa.z) - ma) * ia * g1[1] + b1[1]; a1[2] = (bf_lo(xa.w) - ma) * ia * g1[2] + b1[2]; a1[3] = (bf_hi(xa.w) - ma) * ia * g1[3] + b1[3];
        c0[0] = (bf_lo(xb.x) - mb) * ib * g0[0] + b0[0]; c0[1] = (bf_hi(xb.x) - mb) * ib * g0[1] + b0[1]; c0[2] = (bf_lo(xb.y) - mb) * ib * g0[2] + b0[2]; c0[3] = (bf_hi(xb.y) - mb) * ib * g0[3] + b0[3];
        c1[0] = (bf_lo(xb.z) - mb) * ib * g1[0] + b1[0]; c1[1] = (bf_hi(xb.z) - mb) * ib * g1[1] + b1[1]; c1[2] = (bf_lo(xb.w) - mb) * ib * g1[2] + b1[2]; c1[3] = (bf_hi(xb.w) - mb) * ib * g1[3] + b1[3];
        if (last_chunk) {
            float* o = p.out + O_PCV + ((size_t)(c >> 4) * 128 + s0) * DM + C0 + d0;
            *(f32x4*)o = a0; *(f32x4*)(o + 4) = a1; *(f32x4*)(o + DM) = c0; *(f32x4*)(o + DM + 4) = c1;
        }
        LAS unsigned* vp = (LAS unsigned*)(Vt + d0 * SV + s0);
#pragma unroll
        for (int j = 0; j < 4; ++j) { vp[(j * SV) / 2] = cvt_pk_bf16(a0[j], c0[j]); vp[((4 + j) * SV) / 2] = cvt_pk_bf16(a1[j], c1[j]); }
    }
    __syncthreads();
    f32x4 acc[2][4];
#pragma unroll
    for (int i = 0; i < 2; ++i)
#pragma unroll
        for (int j = 0; j < 4; ++j) acc[i][j] = (f32x4){0.f, 0.f, 0.f, 0.f};
    for (int ks = 0; ks <= wt; ++ks) {
        bf16x8 af[2], bfr[4];
#pragma unroll
        for (int i = 0; i < 2; ++i) af[i] = *(const LAS bf16x8*)(Wt + (32 * wt + 16 * i + fr) * SW + 32 * ks + 8 * fq);
#pragma unroll
        for (int j = 0; j < 4; ++j) bfr[j] = *(const LAS bf16x8*)(Vt + (64 * wd + 16 * j + fr) * SV + 32 * ks + 8 * fq);
#pragma unroll
        for (int i = 0; i < 2; ++i)
#pragma unroll
            for (int j = 0; j < 4; ++j) acc[i][j] = __builtin_amdgcn_mfma_f32_16x16x32_bf16(bfr[j], af[i], acc[i][j], 0, 0, 0);
    }
#pragma unroll
    for (int i = 0; i < 2; ++i) {
        const int t = 32 * wt + 16 * i + fr;
        bf16_t* rowp = act + (size_t)(R0 + t) * DIN + C0 + 64 * wd + 4 * fq;
#pragma unroll
        for (int j = 0; j < 4; ++j) {
            const u32x2 u2 = uu[i][j], z2v = za[i][j];
            const f32x4 a = acc[i][j]; const float b = bs[i];
            const float z0 = bf_lo(z2v.x), z1 = bf_hi(z2v.x), z2 = bf_lo(z2v.y), z3 = bf_hi(z2v.y);
            u32x2 w; w.x = cvt_pk_bf16(gelu_t(bf_lo(u2.x)) * (a[0] + b) * (z0 * sigm(z0)), gelu_t(bf_hi(u2.x)) * (a[1] + b) * (z1 * sigm(z1)));
            w.y = cvt_pk_bf16(gelu_t(bf_lo(u2.y)) * (a[2] + b) * (z2 * sigm(z2)), gelu_t(bf_hi(u2.y)) * (a[3] + b) * (z3 * sigm(z3)));
            *(u32x2*)(rowp + C_U + 16 * j) = w;
        }
    }
    __syncthreads();
}

template <int W>
__device__ __forceinline__ void qpass_strip(const bf16_t* act, bf16_t* Q, int i0, int colg) {
    constexpr int NR = W + 7;
    const int pos0 = i0 & (SEQ - 1);
    const bf16_t* xcol = act + C_XB + colg;
    u32x4 xr[NR];
#pragma unroll
    for (int k = 0; k < NR; ++k) {
        const int d = k - (W - 1);
        if (pos0 + d >= 0) xr[k] = *(const u32x4*)(xcol + (size_t)(i0 + d) * DIN); else xr[k] = (u32x4){0u, 0u, 0u, 0u};
    }
    float S[8];
#pragma unroll
    for (int j = 0; j < 8; ++j) S[j] = 0.f;
#pragma unroll
    for (int k = 0; k < W - 1; ++k) { S[0] += bf_lo(xr[k].x); S[1] += bf_hi(xr[k].x); S[2] += bf_lo(xr[k].y); S[3] += bf_hi(xr[k].y); S[4] += bf_lo(xr[k].z); S[5] += bf_hi(xr[k].z); S[6] += bf_lo(xr[k].w); S[7] += bf_hi(xr[k].w); }
#pragma unroll
    for (int i = 0; i < 8; ++i) {
        const u32x4 x = xr[W - 1 + i], y = xr[i];
        const float xv[8] = {bf_lo(x.x), bf_hi(x.x), bf_lo(x.y), bf_hi(x.y), bf_lo(x.z), bf_hi(x.z), bf_lo(x.w), bf_hi(x.w)};
        const float yv[8] = {bf_lo(y.x), bf_hi(y.x), bf_lo(y.y), bf_hi(y.y), bf_lo(y.z), bf_hi(y.z), bf_lo(y.w), bf_hi(y.w)};
        const int pos = pos0 + i; const float ic = pos + 1 < W ? 1.0f / (float)(pos + 1) : 1.0f / (float)W;
        float qv[8];
#pragma unroll
        for (int j = 0; j < 8; ++j) { S[j] += xv[j]; qv[j] = S[j] * ic - xv[j]; S[j] -= yv[j]; }
        u32x4 o; o.x = cvt_pk_bf16(qv[0], qv[1]); o.y = cvt_pk_bf16(qv[2], qv[3]); o.z = cvt_pk_bf16(qv[4], qv[5]); o.w = cvt_pk_bf16(qv[6], qv[7]);
        *(u32x4*)(Q + (size_t)(i0 + i) * DM + colg) = o;
    }
}
__device__ __forceinline__ void phase_qpass(const Params& p) {
    const int tid = threadIdx.x, lane = tid & 63, wid = __builtin_amdgcn_readfirstlane(tid >> 6), G = gridDim.x, bid = blockIdx.x;
    const bf16_t* act = (const bf16_t*)(p.ws + WS_ACT);
    bf16_t* Q = (bf16_t*)((unsigned char*)p.out + DO_XN);
    const int g = wid & 3, strip = (wid >> 2) * 2 + (lane >> 5), colg = g * 256 + (lane & 31) * 8;
    for (int blk = bid; blk < MPR / 32; blk += G) {
        const int i0 = blk * 32 + strip * 8;
        if (g == 0) qpass_strip<2>(act, Q, i0, colg); else if (g == 1) qpass_strip<4>(act, Q, i0, colg); else if (g == 2) qpass_strip<8>(act, Q, i0, colg); else qpass_strip<16>(act, Q, i0, colg);
    }
    if (wid == 1) for (int it = bid * 64 + lane; it < MSM * 128; it += G * 64) {
        const int i = it >> 7, c8 = (it & 127) * 8, w = 2 << (c8 >> 8);
        const u32x4 x = *(const u32x4*)(act + (size_t)(MPR + i) * DIN + C_XB + c8);
        const float xv[8] = {bf_lo(x.x), bf_hi(x.x), bf_lo(x.y), bf_hi(x.y), bf_lo(x.z), bf_hi(x.z), bf_lo(x.w), bf_hi(x.w)};
        float S[8];
#pragma unroll
        for (int j = 0; j < 8; ++j) S[j] = xv[j];
        const float* sp = p.state_pool + (size_t)i * 15 * DM + c8;
#pragma unroll
        for (int j = 1; j < 16; ++j) {
            const f32x4 h0 = *(const f32x4*)(sp + (size_t)(15 - j) * DM), h1 = *(const f32x4*)(sp + (size_t)(15 - j) * DM + 4);
            const float mk = j < w ? 1.0f : 0.0f;
            S[0] += mk * h0[0]; S[1] += mk * h0[1]; S[2] += mk * h0[2]; S[3] += mk * h0[3]; S[4] += mk * h1[0]; S[5] += mk * h1[1]; S[6] += mk * h1[2]; S[7] += mk * h1[3];
        }
        const float invw = 1.0f / (float)w; float qv[8];
#pragma unroll
        for (int j = 0; j < 8; ++j) qv[j] = S[j] * invw - xv[j];
        u32x4 o; o.x = cvt_pk_bf16(qv[0], qv[1]); o.y = cvt_pk_bf16(qv[2], qv[3]); o.z = cvt_pk_bf16(qv[4], qv[5]); o.w = cvt_pk_bf16(qv[6], qv[7]);
        *(u32x4*)(Q + (size_t)(MPR + i) * DM + c8) = o;
    }
}

__device__ __forceinline__ void phase_mixpool(LAS unsigned char* lds, const Params& p) {
    const int tid = threadIdx.x, lane = tid & 63, wid = tid >> 6, G = gridDim.x, bid = blockIdx.x;
    phase_qpass(p);
    { int hprev = -1; for (int a = bid; a < 128 * 8; a += G) { const int h = a & 7; mix_unit(lds, p, a >> 3, h, h != hprev); hprev = h; } }
    bf16_t* act = (bf16_t*)(p.ws + WS_ACT);
    const float* statv = (const float*)(p.ws + WS_STATV);
    if (wid == 0) for (int r = bid; r < MSM; r += G) {
        const int row = MPR + r;
        float s, q;
        { const f32x2 v = *(const f32x2*)((const float*)(p.ws + WS_SVS) + ((size_t)r * 64 + lane) * 2); s = v.x; q = v.y; }
        s = wave_sum(s); q = wave_sum(q);
        const float mean = s * (1.0f / DM), rstd = 1.0f / sqrtf(fmaxf(q * (1.0f / DM) - mean * mean, 0.f) + EPS);
        bf16_t* rowp = act + (size_t)row * DIN;
#pragma unroll
        for (int i = 0; i < 4; ++i) {
            const int col = lane * 4 + 256 * i, h = col >> 7;
            const u32x2 gv = *(const u32x2*)(rowp + C_V + col), uu = *(const u32x2*)(rowp + C_U + col), za = *(const u32x2*)(rowp + C_ZA + col);
            const f32x4 lg = *(const f32x4*)(p.ln_g + col), lb = *(const f32x4*)(p.ln_b + col);
            const float w00 = p.w_s[(size_t)h * 128 * 128], bs = p.b_s[h * 128];
            f32x4 vn; vn[0] = (bf_lo(gv.x) - mean) * rstd * lg[0] + lb[0]; vn[1] = (bf_hi(gv.x) - mean) * rstd * lg[1] + lb[1];
            vn[2] = (bf_lo(gv.y) - mean) * rstd * lg[2] + lb[2]; vn[3] = (bf_hi(gv.y) - mean) * rstd * lg[3] + lb[3];
            *(f32x4*)(p.out + O_SCV + (size_t)r * DM + col) = vn;
            const float z0 = bf_lo(za.x), z1 = bf_hi(za.x), z2 = bf_lo(za.y), z3 = bf_hi(za.y);
            u32x2 o; o.x = cvt_pk_bf16(gelu_t(bf_lo(uu.x)) * (w00 * vn[0] + bs) * (z0 * sigm(z0)), gelu_t(bf_hi(uu.x)) * (w00 * vn[1] + bs) * (z1 * sigm(z1)));
            o.y = cvt_pk_bf16(gelu_t(bf_lo(uu.y)) * (w00 * vn[2] + bs) * (z2 * sigm(z2)), gelu_t(bf_hi(uu.y)) * (w00 * vn[3] + bs) * (z3 * sigm(z3)));
            *(u32x2*)(rowp + C_U + col) = o;
        }
    }
}

struct Row5 { f32x4 hv[4]; u32x2 tv[4]; f32x4 pv; float q; };
__device__ __forceinline__ void row5_load(const Params& p, int row, int lane, Row5& R) {
    const bf16_t* act = (const bf16_t*)(p.ws + WS_ACT);
    const float* hsrc = row < MPR ? p.x_prompt + (size_t)row * DM : p.x_sample + (size_t)(row - MPR) * DM;
    const float* psrc = row < MPR ? p.p_prompt + (size_t)row * PLE : p.p_sample + (size_t)(row - MPR) * PLE;
    R.q = row < MPR ? (lane < 16 ? ((const float*)(p.ws + WS_STATT))[(size_t)row * 16 + lane] : 0.f) : ((const float*)(p.ws + WS_STS))[(size_t)(row - MPR) * 64 + lane];
#pragma unroll
    for (int i = 0; i < 4; ++i) { const int col = lane * 4 + 256 * i; R.hv[i] = *(const f32x4*)(hsrc + col); R.tv[i] = *(const u32x2*)(act + (size_t)row * DIN + C_T + col); }
    R.pv = *(const f32x4*)(psrc + lane * 4);
}
__device__ __forceinline__ void row5_finish(const Params& p, int row, int lane, Row5& R) {
    bf16_t* arow = (bf16_t*)(p.ws + WS_ACT) + (size_t)row * DIN;
    const float rstd = 1.0f / sqrtf(wave_sum(R.q) * (1.0f / DM) + EPS);
    f32x4 h1[4]; float ss = 0.f;
#pragma unroll
    for (int i = 0; i < 4; ++i) {
        const int col = lane * 4 + 256 * i;
        const f32x4 gv = *(const f32x4*)(p.post_g + col);
        const f32x4 tv = (f32x4){bf_lo(R.tv[i].x), bf_hi(R.tv[i].x), bf_lo(R.tv[i].y), bf_hi(R.tv[i].y)};
        h1[i] = R.hv[i] + tv * rstd * gv;
        ss += (h1[i][0] * h1[i][0] + h1[i][1] * h1[i][1]) + (h1[i][2] * h1[i][2] + h1[i][3] * h1[i][3]);
        *(f32x4*)(p.out + (size_t)row * DM + col) = h1[i];
    }
    const float rstd1 = 1.0f / sqrtf(wave_sum(ss) * (1.0f / DM) + EPS);
#pragma unroll
    for (int i = 0; i < 4; ++i) {
        const int col = lane * 4 + 256 * i;
        const f32x4 gv = *(const f32x4*)(p.ple_in_g + col);
        u32x2 w; w.x = cvt_pk_bf16(h1[i][0] * rstd1 * gv[0], h1[i][1] * rstd1 * gv[1]); w.y = cvt_pk_bf16(h1[i][2] * rstd1 * gv[2], h1[i][3] * rstd1 * gv[3]);
        *(u32x2*)(arow + PLE + col) = w;
    }
    { u32x2 w; w.x = cvt_pk_bf16(R.pv[0], R.pv[1]); w.y = cvt_pk_bf16(R.pv[2], R.pv[3]); *(u32x2*)(arow + lane * 4) = w; }
}
__device__ __forceinline__ void phase_rows5(const Params& p, int first_row) {
    const int tid = threadIdx.x, lane = tid & 63, wid = tid >> 6, G = gridDim.x, bid = blockIdx.x, step = G * 8;
    int row = first_row + bid * 8 + wid;
    for (; row + step < MREAL; row += 2 * step) {
        Row5 a, b; row5_load(p, row, lane, a); row5_load(p, row + step, lane, b);
        row5_finish(p, row, lane, a); row5_finish(p, row + step, lane, b);
    }
    if (row < MREAL) { Row5 a; row5_load(p, row, lane, a); row5_finish(p, row, lane, a); }
}
struct Row7 { f32x4 hv[4]; u32x2 gv[4]; float q; };
__device__ __forceinline__ void row7_load(const Params& p, int row, int lane, Row7& R) {
    const bf16_t* act = (const bf16_t*)(p.ws + WS_ACT);
    R.q = row < MPR ? (lane < 16 ? ((const float*)(p.ws + WS_STATG))[(size_t)row * 16 + lane] : 0.f) : ((const float*)(p.ws + WS_SGS))[(size_t)(row - MPR) * 64 + lane];
#pragma unroll
    for (int i = 0; i < 4; ++i) { const int col = lane * 4 + 256 * i; R.hv[i] = *(const f32x4*)(p.out + (size_t)row * DM + col); R.gv[i] = *(const u32x2*)(act + (size_t)row * DIN + C_GE + col); }
}
__device__ __forceinline__ void row7_finish(const Params& p, int row, int lane, Row7& R) {
    const float rstd = 1.0f / sqrtf(wave_sum(R.q) * (1.0f / DM) + EPS);
#pragma unroll
    for (int i = 0; i < 4; ++i) {
        const int col = lane * 4 + 256 * i;
        const f32x4 g = *(const f32x4*)(p.ple_out_g + col);
        const f32x4 ge = (f32x4){bf_lo(R.gv[i].x), bf_hi(R.gv[i].x), bf_lo(R.gv[i].y), bf_hi(R.gv[i].y)};
        *(f32x4*)(p.out + (size_t)row * DM + col) = R.hv[i] + ge * rstd * g;
    }
}
__device__ __forceinline__ void phase_rows7(const Params& p, int first_row) {
    const int tid = threadIdx.x, lane = tid & 63, wid = tid >> 6, G = gridDim.x, bid = blockIdx.x, step = G * 8;
    int row = first_row + bid * 8 + wid;
    for (; row + step < MREAL; row += 2 * step) {
        Row7 a, b; row7_load(p, row, lane, a); row7_load(p, row + step, lane, b);
        row7_finish(p, row, lane, a); row7_finish(p, row + step, lane, b);
    }
    if (row < MREAL) { Row7 a; row7_load(p, row, lane, a); row7_finish(p, row, lane, a); }
}

__device__ __forceinline__ void wait_tickets(const Params& p, int stage, int rg) {
    unsigned* t = (unsigned*)(p.ws + WS_TICK) + (stage * 4 + rg) * 64; unsigned sp = 0;
    while ((unsigned)__builtin_amdgcn_readfirstlane(__hip_atomic_load(t, __ATOMIC_RELAXED, __HIP_MEMORY_SCOPE_AGENT)) < 64u) { __builtin_amdgcn_s_sleep(2); if (++sp > (1u << 22)) break; }
    __builtin_amdgcn_fence(__ATOMIC_ACQUIRE, "agent"); asm volatile("s_waitcnt vmcnt(0)" ::: "memory");
}
__device__ __forceinline__ void thin_rows5(const Params& p) {
    if ((threadIdx.x >> 6) == 0 && blockIdx.x < MSM) { wait_tickets(p, 0, blockIdx.x >> 5); Row5 a; row5_load(p, MPR + blockIdx.x, threadIdx.x & 63, a); row5_finish(p, MPR + blockIdx.x, threadIdx.x & 63, a); }
}
__device__ __forceinline__ void thin_rows7(const Params& p) {
    if ((threadIdx.x >> 6) == 0 && blockIdx.x < MSM) { wait_tickets(p, 1, blockIdx.x >> 5); Row7 a; row7_load(p, MPR + blockIdx.x, threadIdx.x & 63, a); row7_finish(p, MPR + blockIdx.x, threadIdx.x & 63, a); }
}

__global__ void __launch_bounds__(NTHR, 2) fwd_megakernel(Params p) {
    extern __shared__ __attribute__((aligned(16))) unsigned char lds_raw[];
    LAS unsigned char* lds = (LAS unsigned char*)lds_raw;
    cg::grid_group grid = cg::this_grid();
    const int G = gridDim.x, bid = blockIdx.x;
    bf16_t* act = (bf16_t*)(p.ws + WS_ACT);
    volatile LAS unsigned* xb_st = (volatile LAS unsigned*)(lds + 131072);
    if (threadIdx.x < 4) xb_st[threadIdx.x] = 0u;
    __syncthreads();
    const XcdBarrier xbar = xcd_barrier_post((unsigned*)(p.ws + WS_BAR), xb_st);
#define SEAM() xcd_barrier(xbar)

    phase_prep(lds, p);
    SEAM();
    {
        pg8::Gemm g{(const bf16_t*)((unsigned char*)p.out + DO_XN), (const bf16_t*)((unsigned char*)p.out + DO_WIN), DM, DM, DM, 0};
        pg8::StaticOrder S; S.init(MPR / 256, DIN / 256, G, bid);
        EpiAct E{act, (float*)(p.ws + WS_STATV), p.out};
        pg8::gemm_phase<EpiAct, pg8::StaticOrder, K_ALIGN, K_SP2>(lds, g, S, E);
        small_gemm1<2>(p, g.A, g.lda, g.Bt, g.ldb, g.K, DIN / 32);
    }
    SEAM();
    phase_mixpool(lds, p);
    SEAM();
    {
        pg8::Gemm g{(const bf16_t*)((unsigned char*)p.out + DO_XN), (const bf16_t*)(p.ws + WS_WPOOL), DM, 256, 256, 256 * 2};
        pg8::StaticOrder S; S.init(MPR / 256, 4, G, bid);
        EpiPool E{act, p.pool_scale};
        pg8::gemm_phase<EpiPool, pg8::StaticOrder, K_ALIGN, K_SP2, PreSmall2<2>>(lds, g, S, E, PreSmall2<2>{lds, p, g.A, g.lda, g.Bt, g.ldb});
    }
    SEAM();
    {
        pg8::Gemm g{act + C_U, (const bf16_t*)(p.ws + WS_WCAT), DIN, 2048, 2048, 0};
        pg8::StaticOrder S; S.init(MPR / 256, 4, G, bid);
        EpiMerge E{act};
        pg8::gemm_phase<EpiMerge, pg8::StaticOrder, K_ALIGN, K_SP2, PreSmall2<3>>(lds, g, S, E, PreSmall2<3>{lds, p, g.A, g.lda, g.Bt, g.ldb});
    }
    SEAM();
    const bool fusedn = (G == 256);
    {
        pg8::Gemm g{act + C_M, (const bf16_t*)(p.ws + WS_WOUT), DIN, 1024, 1024, 0};
        pg8::StaticOrder S; S.init(MPR / 256, 4, G, bid);
        if (fusedn) {
            for (int row = bid * 8 + (threadIdx.x >> 6); row < MPR; row += G * 8) {
                const int lane = threadIdx.x & 63; const f32x4 pv = *(const f32x4*)(p.p_prompt + (size_t)row * PLE + lane * 4);
                u32x2 w; w.x = cvt_pk_bf16(pv[0], pv[1]); w.y = cvt_pk_bf16(pv[2], pv[3]); *(u32x2*)(act + (size_t)row * DIN + lane * 4) = w;
            }
            float* xb = (float*)(p.ws + WS_XBUF); unsigned* xc = (unsigned*)(p.ws + WS_XCNT);
            EpiOutF E{act, p.x_prompt, (float*)(p.ws + WS_RSTD1), p.post_g, p.ple_in_g, RowX{xb, xc}, RowX{xb + 64 * 256 * 4, xc + 64 * 64}};
            pg8::gemm_phase<EpiOutF, pg8::StaticOrder, false, K_SP2, PreSmall2<4>>(lds, g, S, E, PreSmall2<4>{lds, p, g.A, g.lda, g.Bt, g.ldb});
        } else {
            EpiOut E{act, (float*)(p.ws + WS_STATT)};
            pg8::gemm_phase<EpiOut, pg8::StaticOrder, K_ALIGN, K_SP2, PreSmall2<4>>(lds, g, S, E, PreSmall2<4>{lds, p, g.A, g.lda, g.Bt, g.ldb});
        }
    }
    if (fusedn) thin_rows5(p);
    SEAM();
    if (!fusedn) { phase_rows5(p, 0); SEAM(); }
    {
        pg8::Gemm g{act, (const bf16_t*)(p.ws + WS_W6), DIN, 1280, 1280, 0};
        pg8::StaticOrder S; S.init(MPR / 256, 4, G, bid);
        if (fusedn) {
            EpiGateF E{act, p.out, p.ple_out_g, p.ple_in_g, (const float*)(p.ws + WS_RSTD1), RowX{(float*)(p.ws + WS_XBUF) + 2 * 64 * 256 * 4, (unsigned*)(p.ws + WS_XCNT) + 2 * 64 * 64}};
            pg8::gemm_phase<EpiGateF, pg8::StaticOrder, false, K_SP2, PreSmall2<6>>(lds, g, S, E, PreSmall2<6>{lds, p, g.A, g.lda, g.Bt, g.ldb});
        } else {
            EpiGate E{act, (float*)(p.ws + WS_STATG)};
            pg8::gemm_phase<EpiGate, pg8::StaticOrder, K_ALIGN, K_SP2, PreSmall2<6>>(lds, g, S, E, PreSmall2<6>{lds, p, g.A, g.lda, g.Bt, g.ldb});
        }
    }
    if (fusedn) thin_rows7(p); else { SEAM(); phase_rows7(p, 0); }
    if (gridDim.y > 1) grid.sync();
}

extern "C" void kernel_launch(void* const* d_in, const int* in_sizes, int n_in, void* d_out, int out_size, void* d_ws, size_t ws_size, hipStream_t stream) {
    constexpr size_t kDynLds = LDS_BYTES;
    static int grid_blocks = 0;
    if (!grid_blocks) {
        if (ws_size < WS_END) { fprintf(stderr, "kernel_launch: workspace too small: %zu < %zu\n", ws_size, (size_t)WS_END); grid_blocks = -1; return; }
        int dev = 0, cus = 0, per_cu = 0;
        (void)hipGetDevice(&dev);
        (void)hipDeviceGetAttribute(&cus, hipDeviceAttributeMultiprocessorCount, dev);
        (void)hipFuncSetAttribute((const void*)fwd_megakernel, hipFuncAttributeMaxDynamicSharedMemorySize, (int)kDynLds);
        (void)hipOccupancyMaxActiveBlocksPerMultiprocessor(&per_cu, (const void*)fwd_megakernel, NTHR, kDynLds);
        if (per_cu < 1) { fprintf(stderr, "kernel_launch: occupancy query says %d blocks per CU\n", per_cu); per_cu = 1; }
        grid_blocks = cus;
    }
    if (grid_blocks < 0) return;
    if (hipMemsetAsync((unsigned char*)d_ws + WS_BAR, 0, ZERO_BYTES, stream) != hipSuccess) { fprintf(stderr, "kernel_launch: memset of the barrier words failed\n"); return; }
    Params p{};
    const float** f = (const float**)&p;
    for (int i = 0; i < 21; ++i) f[i] = (const float*)d_in[i];
    p.out = (float*)d_out; p.ws = (unsigned char*)d_ws;
    void* args[] = {&p};
    hipError_t e = hipLaunchCooperativeKernel((const void*)fwd_megakernel, dim3(grid_blocks), dim3(NTHR), args, kDynLds, stream);
    if (e != hipSuccess) fprintf(stderr, "cooperative launch failed: %s (grid %d)\n", hipGetErrorString(e), grid_blocks);
}
```
